# Optimizing an MI355X kernel written in HIP

```python
import jax, jax.numpy as jnp
from jax import lax
import numpy as np

D_MODEL = 1024
BATCH = 1
SEQ = 16384
DEPTH = 1

N_META = 16
BLOCK = 128
WINDOW = 128
NORM_EPS = 1e-6

SWA_HEADS = 8
SWA_KV_HEADS = 2
SWA_HEAD_DIM = 64
SWA_GROUP = SWA_HEADS // SWA_KV_HEADS
SWA_WIDTH = SWA_HEADS * SWA_HEAD_DIM
SWA_KV_WIDTH = SWA_KV_HEADS * SWA_HEAD_DIM

MLA_HEADS = 8
MLA_Q_LORA = 256
MLA_KV_LORA = 128
MLA_NOPE_DIM = 64
MLA_ROPE_DIM = 32
MLA_V_DIM = 64
MLA_QK_DIM = MLA_NOPE_DIM + MLA_ROPE_DIM
MLA_WIDTH = MLA_HEADS * MLA_V_DIM
ROPE_THETA = 10000.0

MIX_WIDTH = SWA_WIDTH + MLA_WIDTH
IN_SIZES = (SWA_WIDTH, SWA_KV_WIDTH, SWA_KV_WIDTH, MLA_Q_LORA, MLA_KV_LORA, MLA_ROPE_DIM)
IN_WIDTH = SWA_WIDTH + 2 * SWA_KV_WIDTH + MLA_Q_LORA + MLA_KV_LORA + MLA_ROPE_DIM

N_EXPERTS = 32
TOP_K = 4
D_FF = 1024
SWIGLU_LIMIT = 7.0
SWIGLU_ALPHA = 1.702
MOE_BLOCK = 128

kernel_name = "hymba_swa_mla_moe_encoder_block"


def rms_norm(x, g):
    xf = x.astype(jnp.float32)
    y = xf * lax.rsqrt(jnp.mean(xf * xf, axis=-1, keepdims=True) + NORM_EPS)
    return (y * g.astype(jnp.float32)).astype(x.dtype)


def alibi_slopes(n):
    return jnp.asarray(2.0 ** (-8.0 * np.arange(1, n + 1) / n), dtype=jnp.float32)


def apply_rope(x, pos):
    half = x.shape[-1] // 2
    inv = 1.0 / (ROPE_THETA ** (jnp.arange(half, dtype=jnp.float32) / half))
    ang = pos.astype(jnp.float32)[:, None] * inv[None, :]
    cos = jnp.cos(ang)[None, :, None, :]
    sin = jnp.sin(ang)[None, :, None, :]
    xf = x.astype(jnp.float32)
    x1, x2 = xf[..., :half], xf[..., half:]
    return jnp.concatenate([x1 * cos - x2 * sin, x1 * sin + x2 * cos], axis=-1).astype(x.dtype)


def sink_softmax(s, sink):
    m = jnp.maximum(jnp.max(s, axis=-1, keepdims=True), sink)
    p = jnp.exp(s - m)
    return p / (jnp.sum(p, axis=-1, keepdims=True) + jnp.exp(sink - m))


def _band_attend(q, k, v, dist, valid, slopes, sink):
    scale = SWA_HEAD_DIM ** -0.5
    s = jnp.einsum('bnqkgd,bnskd->bnkgqs', q, k, preferred_element_type=jnp.float32) * scale
    bias = -slopes.reshape(SWA_KV_HEADS, SWA_GROUP)[None, :, :, None, None] * dist[:, None, None].astype(jnp.float32)
    s = jnp.where(valid[:, None, None], s + bias, -jnp.inf)
    p = sink_softmax(s, sink.astype(jnp.float32).reshape(SWA_KV_HEADS, SWA_GROUP)[:, :, None, None])
    return jnp.einsum('bnkgqs,bnskd->bnqkgd', p.astype(v.dtype), v)


def windowed_gqa(q, k, v, sink):
    b, L = q.shape[0], q.shape[1]
    S = L - N_META
    nb = S // BLOCK
    slopes = alibi_slopes(SWA_HEADS)
    km, kr = k[:, :N_META], k[:, N_META:]
    vm, vr = v[:, :N_META], v[:, N_META:]

    qm = q[:, :N_META].reshape(b, 1, N_META, SWA_KV_HEADS, SWA_GROUP, SWA_HEAD_DIM)
    k_mb = jnp.concatenate([km, kr[:, :BLOCK]], axis=1)[:, None]
    v_mb = jnp.concatenate([vm, vr[:, :BLOCK]], axis=1)[:, None]
    d_r = N_META + jnp.arange(BLOCK)[None, :] - jnp.arange(N_META)[:, None]
    dist_m = jnp.concatenate([jnp.zeros((N_META, N_META), jnp.int32), d_r], axis=1)[None]
    valid_m = jnp.concatenate([jnp.ones((N_META, N_META), bool), d_r <= WINDOW], axis=1)[None]
    out_m = _band_attend(qm, k_mb, v_mb, dist_m, valid_m, slopes, sink)

    qr = q[:, N_META:].reshape(b, nb, BLOCK, SWA_KV_HEADS, SWA_GROUP, SWA_HEAD_DIM)

    def band(t_real, t_meta):
        tp = jnp.pad(t_real, ((0, 0), (BLOCK, BLOCK), (0, 0), (0, 0)))
        tp = tp.reshape(b, nb + 2, BLOCK, SWA_KV_HEADS, SWA_HEAD_DIM)
        win = jnp.concatenate([tp[:, :-2], tp[:, 1:-1], tp[:, 2:]], axis=2)
        meta = jnp.broadcast_to(t_meta[:, None], (b, nb, N_META, SWA_KV_HEADS, SWA_HEAD_DIM))
        return jnp.concatenate([meta, win], axis=2)

    qpos = jnp.arange(nb)[:, None] * BLOCK + jnp.arange(BLOCK)[None, :]
    kpos = (jnp.arange(nb)[:, None] - 1) * BLOCK + jnp.arange(3 * BLOCK)[None, :]
    d = jnp.abs(qpos[:, :, None] - kpos[:, None, :])
    in_range = (kpos >= 0) & (kpos < S)
    valid_w = (d <= WINDOW) & in_range[:, None, :]
    dist_r = jnp.concatenate([jnp.zeros((nb, BLOCK, N_META), d.dtype), d], axis=-1)
    valid_r = jnp.concatenate([jnp.ones((nb, BLOCK, N_META), bool), valid_w], axis=-1)
    out_r = _band_attend(qr, band(kr, km), band(vr, vm), dist_r, valid_r, slopes, sink)

    return jnp.concatenate([out_m.reshape(b, N_META, SWA_WIDTH), out_r.reshape(b, S, SWA_WIDTH)], axis=1)


def latent_attention(q_lat, kv_lat, k_rope, q_lat_g, w_q_up, kv_lat_g, w_kv_up, q_g, k_g):
    b, L = q_lat.shape[0], q_lat.shape[1]
    S = L - N_META
    nb = S // BLOCK
    pos = jnp.arange(L)
    q = (rms_norm(q_lat, q_lat_g) @ w_q_up).reshape(b, L, MLA_HEADS, MLA_QK_DIM)
    kv = (rms_norm(kv_lat, kv_lat_g) @ w_kv_up).reshape(b, L, MLA_HEADS, MLA_NOPE_DIM + MLA_V_DIM)
    k_nope, v = kv[..., :MLA_NOPE_DIM], kv[..., MLA_NOPE_DIM:]
    k = jnp.concatenate([k_nope, jnp.broadcast_to(k_rope[:, :, None, :], (b, L, MLA_HEADS, MLA_ROPE_DIM))], axis=-1)
    q = rms_norm(q, q_g)
    k = rms_norm(k, k_g)
    q = jnp.concatenate([q[..., :MLA_NOPE_DIM], apply_rope(q[..., MLA_NOPE_DIM:], pos)], axis=-1)
    k = jnp.concatenate([k[..., :MLA_NOPE_DIM], apply_rope(k[..., MLA_NOPE_DIM:], pos)], axis=-1)
    scale = MLA_QK_DIM ** -0.5

    def attend(qb):
        s = jnp.einsum('bqhd,bshd->bhqs', qb, k, preferred_element_type=jnp.float32) * scale
        p = jax.nn.softmax(s, axis=-1)
        return jnp.einsum('bhqs,bshd->bqhd', p.astype(v.dtype), v)

    out_m = attend(q[:, :N_META]).reshape(b, N_META, MLA_WIDTH)
    qr = q[:, N_META:].reshape(b, nb, BLOCK, MLA_HEADS, MLA_QK_DIM).transpose(1, 0, 2, 3, 4)
    out_r = lax.map(attend, qr)
    out_r = out_r.transpose(1, 0, 2, 3, 4).reshape(b, S, MLA_WIDTH)
    return jnp.concatenate([out_m, out_r], axis=1)


def clamped_swiglu(g, u):
    g = jnp.minimum(g, SWIGLU_LIMIT)
    u = jnp.clip(u, -SWIGLU_LIMIT, SWIGLU_LIMIT)
    return (u + 1.0) * (g * jax.nn.sigmoid(SWIGLU_ALPHA * g))


def moe_ffn(h, router_w, router_b, w_gate, b_gate, w_up, b_up, w_down, b_down):
    T, D = h.shape
    logits = jnp.dot(h, router_w, preferred_element_type=jnp.float32) + router_b.astype(jnp.float32)
    top_logit, top_idx = lax.top_k(logits, TOP_K)
    gate = jax.nn.softmax(top_logit, axis=-1)
    TK = T * TOP_K
    flat_e = top_idx.reshape(TK)
    flat_tok = jnp.repeat(jnp.arange(T, dtype=jnp.int32), TOP_K)
    flat_g = gate.reshape(TK)
    order = jnp.argsort(flat_e)
    se, stok, sg = flat_e[order], flat_tok[order], flat_g[order]
    counts = jnp.bincount(flat_e, length=N_EXPERTS)
    padded = (counts + MOE_BLOCK - 1) // MOE_BLOCK * MOE_BLOCK
    pad_end = jnp.cumsum(padded)
    pad_start = pad_end - padded
    start = jnp.cumsum(counts) - counts
    dest = pad_start[se] + jnp.arange(TK, dtype=jnp.int32) - start[se]
    n_blocks = (TK + N_EXPERTS * (MOE_BLOCK - 1)) // MOE_BLOCK
    P = n_blocks * MOE_BLOCK
    slot_tok = jnp.zeros((P,), jnp.int32).at[dest].set(stok)
    slot_gate = jnp.zeros((P,), jnp.float32).at[dest].set(sg)
    block_e = jnp.minimum(jnp.searchsorted(pad_end, jnp.arange(n_blocks) * MOE_BLOCK, side='right'), N_EXPERTS - 1)
    xs = h[slot_tok].reshape(n_blocks, MOE_BLOCK, D)

    def expert_block(args):
        xb, e = args
        g = xb @ w_gate[e] + b_gate[e]
        u = xb @ w_up[e] + b_up[e]
        return clamped_swiglu(g, u) @ w_down[e] + b_down[e]

    ys = lax.map(expert_block, (xs, block_e)).reshape(P, D)
    ys = (ys.astype(jnp.float32) * slot_gate[:, None]).astype(h.dtype)
    return jnp.zeros_like(h).at[slot_tok].add(ys)


def setup_inputs(seed: int = 0) -> dict:
    key = jax.random.key(seed)
    ks = jax.random.split(key, 24)
    f32 = jnp.float32

    def nrm(k, shape, scale):
        return jax.random.normal(k, shape, f32) * scale

    def gain(k, shape):
        return 1.0 + 0.05 * jax.random.normal(k, shape, f32)

    L = DEPTH
    return {
        "x": nrm(ks[0], (BATCH, SEQ, D_MODEL), 1.0),
        "meta_tokens": nrm(ks[1], (N_META, D_MODEL), 1.0),
        "attn_norm_g": gain(ks[2], (L, D_MODEL)),
        "w_in": nrm(ks[3], (L, D_MODEL, IN_WIDTH), D_MODEL ** -0.5),
        "swa_q_norm_g": gain(ks[4], (L, SWA_HEAD_DIM)),
        "swa_k_norm_g": gain(ks[5], (L, SWA_HEAD_DIM)),
        "swa_sink": nrm(ks[6], (L, SWA_HEADS), 0.5),
        "mla_q_lat_norm_g": gain(ks[7], (L, MLA_Q_LORA)),
        "w_mla_q_up": nrm(ks[8], (L, MLA_Q_LORA, MLA_HEADS * MLA_QK_DIM), MLA_Q_LORA ** -0.5),
        "mla_kv_lat_norm_g": gain(ks[9], (L, MLA_KV_LORA)),
        "w_mla_kv_up": nrm(ks[10], (L, MLA_KV_LORA, MLA_HEADS * (MLA_NOPE_DIM + MLA_V_DIM)), MLA_KV_LORA ** -0.5),
        "mla_q_norm_g": gain(ks[11], (L, MLA_QK_DIM)),
        "mla_k_norm_g": gain(ks[12], (L, MLA_QK_DIM)),
        "w_out": nrm(ks[13], (L, MIX_WIDTH, D_MODEL), MIX_WIDTH ** -0.5),
        "ffn_norm_g": gain(ks[14], (L, D_MODEL)),
        "router_w": nrm(ks[15], (L, D_MODEL, N_EXPERTS), D_MODEL ** -0.5),
        "router_b": nrm(ks[16], (L, N_EXPERTS), 0.01),
        "w_gate": nrm(ks[17], (L, N_EXPERTS, D_MODEL, D_FF), D_MODEL ** -0.5),
        "b_gate": nrm(ks[18], (L, N_EXPERTS, D_FF), 0.01),
        "w_up": nrm(ks[19], (L, N_EXPERTS, D_MODEL, D_FF), D_MODEL ** -0.5),
        "b_up": nrm(ks[20], (L, N_EXPERTS, D_FF), 0.01),
        "w_down": nrm(ks[21], (L, N_EXPERTS, D_FF, D_MODEL), D_FF ** -0.5),
        "b_down": nrm(ks[22], (L, N_EXPERTS, D_MODEL), 0.01),
    }


def reference(x, meta_tokens, attn_norm_g, w_in, swa_q_norm_g, swa_k_norm_g, swa_sink,
              mla_q_lat_norm_g, w_mla_q_up, mla_kv_lat_norm_g, w_mla_kv_up, mla_q_norm_g,
              mla_k_norm_g, w_out, ffn_norm_g, router_w, router_b, w_gate, b_gate, w_up, b_up,
              w_down, b_down):
    b, S, D = x.shape
    meta = jnp.broadcast_to(meta_tokens.astype(x.dtype)[None], (b, N_META, D))
    h = jnp.concatenate([meta, x], axis=1)
    L = h.shape[1]
    split_at = [int(i) for i in np.cumsum(IN_SIZES)[:-1]]
    for l in range(DEPTH):
        a = rms_norm(h, attn_norm_g[l])
        proj = a @ w_in[l]
        q_s, k_s, v_s, q_lat, kv_lat, k_rope = jnp.split(proj, split_at, axis=-1)
        q_s = rms_norm(q_s.reshape(b, L, SWA_HEADS, SWA_HEAD_DIM), swa_q_norm_g[l])
        k_s = rms_norm(k_s.reshape(b, L, SWA_KV_HEADS, SWA_HEAD_DIM), swa_k_norm_g[l])
        v_s = v_s.reshape(b, L, SWA_KV_HEADS, SWA_HEAD_DIM)
        y_a = windowed_gqa(q_s, k_s, v_s, swa_sink[l])
        y_b = latent_attention(q_lat, kv_lat, k_rope, mla_q_lat_norm_g[l], w_mla_q_up[l],
                               mla_kv_lat_norm_g[l], w_mla_kv_up[l], mla_q_norm_g[l], mla_k_norm_g[l])
        h = h + jnp.concatenate([y_a, y_b], axis=-1) @ w_out[l]
        m = rms_norm(h, ffn_norm_g[l]).reshape(b * L, D)
        h = h + moe_ffn(m, router_w[l], router_b[l], w_gate[l], b_gate[l], w_up[l], b_up[l],
                        w_down[l], b_down[l]).reshape(b, L, D)
    return h[:, N_META:]
```

```cpp
#include <hip/hip_runtime.h>
#include <cstdio>
#include <cstdint>
#include <cmath>
#ifndef MK_ONE_LAUNCH
#define MK_ONE_LAUNCH 1
#endif
namespace pg8 {
#define PG8_LAS __attribute__((address_space(3)))
typedef unsigned short bf16_t;
typedef short bf16x8 __attribute__((ext_vector_type(8)));
typedef float f32x4 __attribute__((ext_vector_type(4)));
typedef unsigned u32x4 __attribute__((ext_vector_type(4)));
constexpr int BM = 256, BK = 64, HALF = 128, HTB = HALF * BK * 2  , STAGE_BYTES = 8 * HTB, NXCD = 8, WGM = 8;

__host__ __device__ __forceinline__ int lds_byte(int r, int c) { const int st = (r >> 4) * 2 + (c >> 5), rr = r & 15, cc = c & 31, ob = rr * 64 + cc * 2; return st * 1024 + (ob ^ (((ob >> 9) & 1) << 5)); }
__host__ __device__ __forceinline__ void stage_rc(int b, int& R, int& C) { const int st = b / 1024, sb = b % 1024, swz = sb ^ (((sb >> 9) & 1) << 5); R = (st >> 1) * 16 + swz / 64; C = (st & 1) * 32 + (swz % 64) / 2; }
__host__ __device__ __forceinline__ int perm32(int rho) { const int n = rho >> 4, i = rho & 15; return 8 * (i >> 2) + 4 * n + (i & 3); }

struct Unit { int pm, pn, e, pl; };
struct Gemm { const bf16_t* A; const bf16_t* Bt; int M, N, K; int lda; };

struct StaticOrder {
    int nM, nN, nwg, G, c;
    __host__ __device__ void init(int M, int N, int G_, int c_) { nM = M / BM; nN = N / BM; nwg = nM * nN; G = G_; c = c_; }
    __host__ __device__ bool next(int i, Unit& u) const {
        const long L = (long)i * G + c; if (L >= nwg) return false;
        int wgid = (int)L; { const int q = nwg / NXCD, r = nwg % NXCD, xcd = wgid % NXCD, off = wgid / NXCD; wgid = (xcd < r ? xcd * (q + 1) : r * (q + 1) + (xcd - r) * q) + off; }
        const int nig = WGM * nN, gid = wgid / nig, fm = gid * WGM, gsz = (nM - fm) < WGM ? (nM - fm) : WGM;
        u.pm = fm + ((wgid % nig) % gsz); u.pn = (wgid % nig) / gsz; return true;
    }
    __device__ __forceinline__ void a_ready(const Unit&) const {}
    __device__ __forceinline__ void done(const Unit&) const {}
};


__device__ __forceinline__ unsigned cvt_pk_bf16(float lo, float hi) { unsigned r; asm volatile("v_cvt_pk_bf16_f32 %0, %1, %2" : "=v"(r) : "v"(lo), "v"(hi)); return r; }

struct EpiBf16 {
    static constexpr bool PERM = true, AFTER_DRAIN = false;
    bf16_t* O; int ldc;
    __device__ __forceinline__ void operator()(const f32x4 (&acc)[2][2][4][2], const Unit& u, int wr, int wc, int fr, int fq) const {
        const int row0 = u.pm * BM + wr * 64 + fr, col0 = u.pn * BM + wc * 32 + 8 * fq;
#pragma unroll
        for (int ai = 0; ai < 2; ++ai)
#pragma unroll
            for (int m = 0; m < 4; ++m) { bf16_t* rowp = O + (size_t)(row0 + ai * HALF + m * 16) * ldc + col0;
#pragma unroll
                for (int bj = 0; bj < 2; ++bj) { const f32x4 v0 = acc[ai][bj][m][0], v1 = acc[ai][bj][m][1];
                    u32x4 w; w.x = cvt_pk_bf16(v0[0], v0[1]); w.y = cvt_pk_bf16(v0[2], v0[3]); w.z = cvt_pk_bf16(v1[0], v1[1]); w.w = cvt_pk_bf16(v1[2], v1[3]);
                    *(u32x4*)(rowp + bj * HALF) = w; } }
    }
};
struct EpiBf16S {
    static constexpr bool PERM = true, AFTER_DRAIN = false;
    bf16_t* O; int ldc; float sc;
    __device__ __forceinline__ void operator()(const f32x4 (&acc)[2][2][4][2], const Unit& u, int wr, int wc, int fr, int fq) const {
        const int row0 = u.pm * BM + wr * 64 + fr, col0 = u.pn * BM + wc * 32 + 8 * fq;
#pragma unroll
        for (int ai = 0; ai < 2; ++ai)
#pragma unroll
            for (int m = 0; m < 4; ++m) { bf16_t* rowp = O + (size_t)(row0 + ai * HALF + m * 16) * ldc + col0;
#pragma unroll
                for (int bj = 0; bj < 2; ++bj) { const f32x4 v0 = acc[ai][bj][m][0] * sc, v1 = acc[ai][bj][m][1] * sc;
                    u32x4 w; w.x = cvt_pk_bf16(v0[0], v0[1]); w.y = cvt_pk_bf16(v0[2], v0[3]); w.z = cvt_pk_bf16(v1[0], v1[1]); w.w = cvt_pk_bf16(v1[2], v1[3]);
                    *(u32x4*)(rowp + bj * HALF) = w; } }
    }
};
struct EpiResF32 {
    static constexpr bool PERM = false, AFTER_DRAIN = false;
    const float* base; float* out; int ldc;
    __device__ __forceinline__ void operator()(const f32x4 (&acc)[2][2][4][2], const Unit& u, int wr, int wc, int fr, int fq) const {
        const int row0 = u.pm * BM + wr * 64 + fr, col0 = u.pn * BM + wc * 32 + 4 * fq;
#pragma unroll
        for (int ai = 0; ai < 2; ++ai)
#pragma unroll
            for (int m = 0; m < 4; ++m) { const size_t off = (size_t)(row0 + ai * HALF + m * 16) * ldc + col0;
#pragma unroll
                for (int bj = 0; bj < 2; ++bj)
#pragma unroll
                    for (int n = 0; n < 2; ++n) { const f32x4 b = *(const f32x4*)(base + off + bj * HALF + n * 16); *(f32x4*)(out + off + bj * HALF + n * 16) = b + acc[ai][bj][m][n]; } }
    }
};
struct EpiResBf16 {
    static constexpr bool PERM = true, AFTER_DRAIN = false;
    const float* base; bf16_t* out; int ldc;
    __device__ __forceinline__ void operator()(const f32x4 (&acc)[2][2][4][2], const Unit& u, int wr, int wc, int fr, int fq) const {
        const int row0 = u.pm * BM + wr * 64 + fr, col0 = u.pn * BM + wc * 32 + 8 * fq;
#pragma unroll
        for (int ai = 0; ai < 2; ++ai)
#pragma unroll
            for (int m = 0; m < 4; ++m) { const size_t off = (size_t)(row0 + ai * HALF + m * 16) * ldc + col0;
#pragma unroll
                for (int bj = 0; bj < 2; ++bj) { const f32x4 v0 = *(const f32x4*)(base + off + bj * HALF) + acc[ai][bj][m][0], v1 = *(const f32x4*)(base + off + bj * HALF + 4) + acc[ai][bj][m][1];
                    u32x4 w; w.x = cvt_pk_bf16(v0[0], v0[1]); w.y = cvt_pk_bf16(v0[2], v0[3]); w.z = cvt_pk_bf16(v1[0], v1[1]); w.w = cvt_pk_bf16(v1[2], v1[3]);
                    *(u32x4*)(out + off + bj * HALF) = w; } }
    }
};
struct EpiResBf16S {
    static constexpr bool PERM = true, AFTER_DRAIN = false;
    const float* base; bf16_t* out; int ldc; float sc;
    __device__ __forceinline__ void operator()(const f32x4 (&acc)[2][2][4][2], const Unit& u, int wr, int wc, int fr, int fq) const {
        const int row0 = u.pm * BM + wr * 64 + fr, col0 = u.pn * BM + wc * 32 + 8 * fq;
#pragma unroll
        for (int ai = 0; ai < 2; ++ai)
#pragma unroll
            for (int m = 0; m < 4; ++m) { const size_t off = (size_t)(row0 + ai * HALF + m * 16) * ldc + col0;
#pragma unroll
                for (int bj = 0; bj < 2; ++bj) { const f32x4 v0 = *(const f32x4*)(base + off + bj * HALF) + acc[ai][bj][m][0] * sc, v1 = *(const f32x4*)(base + off + bj * HALF + 4) + acc[ai][bj][m][1] * sc;
                    u32x4 w; w.x = cvt_pk_bf16(v0[0], v0[1]); w.y = cvt_pk_bf16(v0[2], v0[3]); w.z = cvt_pk_bf16(v1[0], v1[1]); w.w = cvt_pk_bf16(v1[2], v1[3]);
                    *(u32x4*)(out + off + bj * HALF) = w; } }
    }
};
__device__ __forceinline__ float swiglu1(float g, float u) {
    g = fminf(g, 7.0f); u = fminf(fmaxf(u, -7.0f), 7.0f);
    const float s = __builtin_amdgcn_rcpf(1.0f + __builtin_amdgcn_exp2f(-1.702f * 1.4426950408889634f * g));
    return (u + 1.0f) * (g * s);
}
struct EpiSwiglu {
    static constexpr bool PERM = true, AFTER_DRAIN = false;
    bf16_t* O; const float* bg; const float* bu;
    __device__ __forceinline__ void operator()(const f32x4 (&acc)[2][2][4][2], const Unit& u, int wr, int wc, int fr, int fq) const {
        const int row0 = u.pm * BM + wr * 64 + fr, col0 = u.pl * HALF + wc * 32 + 8 * fq;
        f32x4 bgv[2], buv[2];
#pragma unroll
        for (int n = 0; n < 2; ++n) { bgv[n] = *(const f32x4*)(bg + u.e * 1024 + col0 + 4 * n); buv[n] = *(const f32x4*)(bu + u.e * 1024 + col0 + 4 * n); }
#pragma unroll
        for (int ai = 0; ai < 2; ++ai)
#pragma unroll
            for (int m = 0; m < 4; ++m) { bf16_t* rowp = O + (size_t)(row0 + ai * HALF + m * 16) * 1024 + col0;
                float r[8];
#pragma unroll
                for (int n = 0; n < 2; ++n) { const f32x4 g = acc[ai][0][m][n] + bgv[n], up = acc[ai][1][m][n] + buv[n];
#pragma unroll
                    for (int i = 0; i < 4; ++i) r[4 * n + i] = swiglu1(g[i], up[i]); }
                u32x4 w; w.x = cvt_pk_bf16(r[0], r[1]); w.y = cvt_pk_bf16(r[2], r[3]); w.z = cvt_pk_bf16(r[4], r[5]); w.w = cvt_pk_bf16(r[6], r[7]);
                *(u32x4*)rowp = w; }
    }
};
struct EpiDown {
    static constexpr bool PERM = true, AFTER_DRAIN = false;
    bf16_t* O; const float* bd; const float* sg; float ascale;
    __device__ __forceinline__ void operator()(const f32x4 (&acc)[2][2][4][2], const Unit& u, int wr, int wc, int fr, int fq) const {
        const int row0 = u.pm * BM + wr * 64 + fr, col0 = u.pl * BM + wc * 32 + 8 * fq;
        f32x4 bv[2][2];
#pragma unroll
        for (int bj = 0; bj < 2; ++bj)
#pragma unroll
            for (int n = 0; n < 2; ++n) bv[bj][n] = *(const f32x4*)(bd + u.e * 1024 + col0 + bj * HALF + 4 * n);
#pragma unroll
        for (int ai = 0; ai < 2; ++ai)
#pragma unroll
            for (int m = 0; m < 4; ++m) { const int row = row0 + ai * HALF + m * 16; const float gt = sg[row]; bf16_t* rowp = O + (size_t)row * 1024 + col0;
#pragma unroll
                for (int bj = 0; bj < 2; ++bj) { const f32x4 v0 = (acc[ai][bj][m][0] * ascale + bv[bj][0]) * gt, v1 = (acc[ai][bj][m][1] * ascale + bv[bj][1]) * gt;
                    u32x4 w; w.x = cvt_pk_bf16(v0[0], v0[1]); w.y = cvt_pk_bf16(v0[2], v0[3]); w.z = cvt_pk_bf16(v1[0], v1[1]); w.w = cvt_pk_bf16(v1[2], v1[3]);
                    *(u32x4*)(rowp + bj * HALF) = w; } }
    }
};
__device__ __forceinline__ unsigned pk4_fp8(float a, float b, float c, float d) {
    a = __builtin_amdgcn_fmed3f(a, -448.f, 448.f); b = __builtin_amdgcn_fmed3f(b, -448.f, 448.f); c = __builtin_amdgcn_fmed3f(c, -448.f, 448.f); d = __builtin_amdgcn_fmed3f(d, -448.f, 448.f);
    int w = 0; w = __builtin_amdgcn_cvt_pk_fp8_f32(a, b, w, false); w = __builtin_amdgcn_cvt_pk_fp8_f32(c, d, w, true); return (unsigned)w;
}
struct EpiSwiglu8 {
    static constexpr bool PERM = true, AFTER_DRAIN = false;
    unsigned char* O; const float* bg; const float* bu;
    __device__ __forceinline__ void operator()(const f32x4 (&acc)[2][2][4][2], const Unit& u, int wr, int wc, int fr, int fq) const {
        const int row0 = u.pm * BM + wr * 64 + fr, col0 = u.pl * HALF + wc * 32 + 8 * fq;
        f32x4 bgv[2], buv[2];
#pragma unroll
        for (int n = 0; n < 2; ++n) { bgv[n] = *(const f32x4*)(bg + u.e * 1024 + col0 + 4 * n); buv[n] = *(const f32x4*)(bu + u.e * 1024 + col0 + 4 * n) + 1.0f; }
#pragma unroll
        for (int ai = 0; ai < 2; ++ai)
#pragma unroll
            for (int m = 0; m < 4; ++m) { unsigned char* rowp = O + (size_t)(row0 + ai * HALF + m * 16) * 1024 + col0;
                float r[8];
#pragma unroll
                for (int n = 0; n < 2; ++n) { const f32x4 g4 = acc[ai][0][m][n] * (1.0f / 2048.0f) + bgv[n], u4 = acc[ai][1][m][n] * (1.0f / 2048.0f) + buv[n];
#pragma unroll
                    for (int i = 0; i < 4; ++i) { const float g = fminf(g4[i], 7.0f), u1 = __builtin_amdgcn_fmed3f(u4[i], -6.0f, 8.0f);
                        const float e = __builtin_amdgcn_exp2f(g * (-1.702f * 1.4426950408889634f));
                        r[4 * n + i] = (g * __builtin_amdgcn_rcpf(__builtin_fmaf(e, 0.125f, 0.125f))) * u1; } }
                int w0 = 0, w1 = 0;
                w0 = __builtin_amdgcn_cvt_pk_fp8_f32(r[0], r[1], w0, false); w0 = __builtin_amdgcn_cvt_pk_fp8_f32(r[2], r[3], w0, true);
                w1 = __builtin_amdgcn_cvt_pk_fp8_f32(r[4], r[5], w1, false); w1 = __builtin_amdgcn_cvt_pk_fp8_f32(r[6], r[7], w1, true);
                typedef unsigned u32x2v __attribute__((ext_vector_type(2)));
                *(u32x2v*)rowp = (u32x2v){(unsigned)w0, (unsigned)w1}; }
    }
};
struct EpiDown8 {
    static constexpr bool PERM = true, AFTER_DRAIN = false;
    unsigned char* O; const float* bd; const float* sg; float ascale;
    __device__ __forceinline__ void operator()(const f32x4 (&acc)[2][2][4][2], const Unit& u, int wr, int wc, int fr, int fq) const {
        const int row0 = u.pm * BM + wr * 64 + fr, col0 = u.pl * BM + wc * 32 + 8 * fq;
        f32x4 bv[2][2];
#pragma unroll
        for (int bj = 0; bj < 2; ++bj)
#pragma unroll
            for (int n = 0; n < 2; ++n) bv[bj][n] = *(const f32x4*)(bd + u.e * 1024 + col0 + bj * HALF + 4 * n);
#pragma unroll
        for (int ai = 0; ai < 2; ++ai)
#pragma unroll
            for (int m = 0; m < 4; ++m) { const int row = row0 + ai * HALF + m * 16; const float gt = sg[row] * 16.0f; unsigned char* rowp = O + (size_t)row * 1024 + col0;
#pragma unroll
                for (int bj = 0; bj < 2; ++bj) { const f32x4 v0 = (acc[ai][bj][m][0] * ascale + bv[bj][0]) * gt, v1 = (acc[ai][bj][m][1] * ascale + bv[bj][1]) * gt;
                    typedef unsigned u32x2v __attribute__((ext_vector_type(2)));
                    *(u32x2v*)(rowp + bj * HALF) = (u32x2v){pk4_fp8(v0[0], v0[1], v0[2], v0[3]), pk4_fp8(v1[0], v1[1], v1[2], v1[3])}; } }
    }
};
struct MoeOrder {
    int nM, nN, nwg, G, c; const PG8_LAS int* tile_e;
    __device__ void init(int nM_, int nN_, int G_, int c_, const PG8_LAS int* te) { nM = nM_; nN = nN_; nwg = nM * nN; G = G_; c = c_; tile_e = te; }
    __device__ bool next(int i, Unit& u) const {
        const long L = (long)i * G + c; if (L >= nwg) return false;
        int wgid = (int)L; { const int q = nwg / NXCD, r = nwg % NXCD, xcd = wgid % NXCD, off = wgid / NXCD; wgid = (xcd < r ? xcd * (q + 1) : r * (q + 1) + (xcd - r) * q) + off; }
        const int nig = WGM * nN, gid = wgid / nig, fm = gid * WGM, gsz = (nM - fm) < WGM ? (nM - fm) : WGM;
        u.pm = fm + ((wgid % nig) % gsz); u.pl = (wgid % nig) / gsz; u.e = tile_e[u.pm]; u.pn = u.e * nN + u.pl; return true;
    }
    __device__ __forceinline__ void a_ready(const Unit&) const {}
    __device__ __forceinline__ void done(const Unit&) const {}
};
typedef int i32x8 __attribute__((ext_vector_type(8)));
typedef int i32x4v __attribute__((ext_vector_type(4)));
template <class Epi, class Sched, bool ALIGN_EPI = false, bool SP2 = false, bool F8 = false>
__device__ __forceinline__ void gemm_phase(PG8_LAS unsigned char* lds, const Gemm g, const Sched& S, const Epi& E) {
    const int tid = threadIdx.x, wid = __builtin_amdgcn_readfirstlane(tid >> 6), lane = tid & 63, wr = wid >> 2, wc = wid & 3, fr = lane & 15, fq = lane >> 4;
    const int K = g.K, nt = K / BK, LDA = g.lda ? g.lda : g.K;
    unsigned voffA[2], voffB[2];
#pragma unroll
    for (int i = 0; i < 2; ++i) { int R, C; stage_rc(tid * 16 + i * 8192, R, C); const int Rb = Epi::PERM ? ((R & ~31) + perm32(R & 31)) : R;
        voffA[i] = (unsigned)(R * LDA + C) * 2u; voffB[i] = (unsigned)(Rb * K + C) * 2u; }
    const size_t kstep = (size_t)(BK * 2);
    const size_t hstep = (size_t)HALF * K * 2;
    const size_t tstep = 2 * hstep; const size_t hstepA = (size_t)HALF * LDA * 2, tstepA = 2 * hstepA;
    const unsigned ldsw = (unsigned)wid * 1024u;
    const int aoff = lds_byte(wr * 64 + fr, fq * 8), boff = lds_byte(wc * 32 + fr, fq * 8);
#define PG8_SA(b, h) (((b) * 2 + (h)) * HTB)
#define PG8_SB(b, h) ((4 + (b) * 2 + (h)) * HTB)
#define PG8_STAGE(bufoff, gbase, voff) do { _Pragma("unroll") for (int _i = 0; _i < 2; ++_i) \
        __builtin_amdgcn_global_load_lds((const unsigned*)((const char*)(gbase) + (voff)[_i]), (PG8_LAS unsigned*)(lds + (bufoff) + ldsw + _i * 8192), 16, 0, 0); } while (0)
#define PG8_LDA(dst, b, h) do { _Pragma("unroll") for (int m = 0; m < 4; ++m) { if constexpr (F8) { dst##8[m].lo = *(const PG8_LAS i32x4v*)(lds + PG8_SA(b, h) + aoff + m * 2048); dst##8[m].hi = *(const PG8_LAS i32x4v*)(lds + PG8_SA(b, h) + aoff + m * 2048 + 1024); } else { _Pragma("unroll") for (int k = 0; k < 2; ++k) dst[m][k] = *(const PG8_LAS bf16x8*)(lds + PG8_SA(b, h) + aoff + m * 2048 + k * 1024); } } } while (0)
#define PG8_LDB(dst, b, h) do { _Pragma("unroll") for (int n = 0; n < 2; ++n) { if constexpr (F8) { dst##8[n].lo = *(const PG8_LAS i32x4v*)(lds + PG8_SB(b, h) + boff + n * 2048); dst##8[n].hi = *(const PG8_LAS i32x4v*)(lds + PG8_SB(b, h) + boff + n * 2048 + 1024); } else { _Pragma("unroll") for (int k = 0; k < 2; ++k) dst[n][k] = *(const PG8_LAS bf16x8*)(lds + PG8_SB(b, h) + boff + n * 2048 + k * 1024); } } } while (0)
#define PG8_MMA(ai, bj, At, Bt) do { __builtin_amdgcn_s_setprio(1); _Pragma("unroll") for (int m = 0; m < 4; ++m) _Pragma("unroll") for (int n = 0; n < 2; ++n) { if constexpr (F8) asm volatile("v_mfma_scale_f32_16x16x128_f8f6f4 %0, %1, %2, %0, %3, %3 op_sel_hi:[0,0,0]" : "+v"(acc[ai][bj][m][n]) : "v"(Bt##8[n]), "v"(At##8[m]), "v"(0x7f7f7f7f)); else { _Pragma("unroll") for (int k = 0; k < 2; ++k) acc[ai][bj][m][n] = __builtin_amdgcn_mfma_f32_16x16x32_bf16(Bt[n][k], At[m][k], acc[ai][bj][m][n], 0, 0, 0); } } __builtin_amdgcn_s_setprio(0); } while (0)
#define PG8_WAIT_V(n) asm volatile("s_waitcnt vmcnt(" #n ")" ::: "memory")
#define PG8_WAIT_L(n) asm volatile("s_waitcnt lgkmcnt(" #n ")" ::: "memory")
#define PG8_BAR __builtin_amdgcn_s_barrier()
#define PG8_SCHED __builtin_amdgcn_sched_barrier(0)
    Unit cur, nxt; int ui = 0;
    if (!S.next(0, cur)) return;
    f32x4 acc[2][2][4][2];
#pragma unroll
    for (int a = 0; a < 2; ++a)
#pragma unroll
        for (int b = 0; b < 2; ++b)
#pragma unroll
            for (int m = 0; m < 4; ++m)
#pragma unroll
                for (int n = 0; n < 2; ++n) acc[a][b][m][n] = (f32x4){0.f, 0.f, 0.f, 0.f};
    bf16x8 At[4][2], B0[2][2], B1[2][2]; i32x8 At8[4], B08[2], B18[2];
    const char* cA = (const char*)g.A + (size_t)cur.pm * tstepA; const char* cB = (const char*)g.Bt + (size_t)cur.pn * tstep;
    S.a_ready(cur);
    if constexpr (SP2) {
        PG8_STAGE(PG8_SB(0, 0), cB, voffB); PG8_STAGE(PG8_SB(0, 1), cB + hstep, voffB); PG8_STAGE(PG8_SA(0, 0), cA, voffA); PG8_STAGE(PG8_SA(0, 1), cA + hstepA, voffA);
        if (wr == 1) PG8_BAR;
        PG8_WAIT_V(2); PG8_BAR;
        PG8_STAGE(PG8_SB(1, 0), cB + kstep, voffB); PG8_STAGE(PG8_SA(1, 0), cA + kstep, voffA); PG8_STAGE(PG8_SB(1, 1), cB + hstep + kstep, voffB);
        PG8_WAIT_V(6); PG8_BAR;
    } else {
        PG8_STAGE(PG8_SB(0, 0), cB, voffB); PG8_STAGE(PG8_SA(0, 0), cA, voffA); PG8_STAGE(PG8_SB(0, 1), cB + hstep, voffB); PG8_STAGE(PG8_SA(0, 1), cA + hstepA, voffA);
        if (wr == 1) PG8_BAR;
        PG8_WAIT_V(4); PG8_BAR;
        PG8_STAGE(PG8_SB(1, 0), cB + kstep, voffB); PG8_STAGE(PG8_SA(1, 0), cA + kstep, voffA); PG8_STAGE(PG8_SB(1, 1), cB + hstep + kstep, voffB);
        PG8_WAIT_V(6); PG8_BAR;
    }
    for (;;) {
        const bool has_next = S.next(ui + 1, nxt);
        const char* nA = has_next ? (const char*)g.A + (size_t)nxt.pm * tstepA : cA; const char* nB = has_next ? (const char*)g.Bt + (size_t)nxt.pn * tstep : cB;
        for (int t = 0; t < nt; t += 2) {
            const bool last = (t == nt - 2);
            const char* a1 = cA + (size_t)(t + 1) * kstep;
            const char* a2 = last ? nA : cA + (size_t)(t + 2) * kstep; const char* b2 = last ? nB : cB + (size_t)(t + 2) * kstep;
            const char* a3 = a2 + kstep; const char* b3 = b2 + kstep;
            if (last && has_next) S.a_ready(nxt);
            if constexpr (SP2) {
            PG8_LDB(B0, 0, 0); PG8_LDB(B1, 0, 1); PG8_SCHED; PG8_LDA(At, 0, 0); PG8_STAGE(PG8_SA(1, 1), a1 + hstepA, voffA);
            PG8_WAIT_V(8); PG8_WAIT_L(0); PG8_BAR; PG8_MMA(0, 0, At, B0); PG8_MMA(0, 1, At, B1); PG8_BAR; PG8_SCHED;
            PG8_LDA(At, 0, 1); PG8_STAGE(PG8_SB(0, 0), b2, voffB); PG8_STAGE(PG8_SB(0, 1), b2 + hstep, voffB); PG8_STAGE(PG8_SA(0, 0), a2, voffA);
            PG8_WAIT_V(8); PG8_WAIT_L(0); PG8_BAR; PG8_MMA(1, 0, At, B0); PG8_MMA(1, 1, At, B1); PG8_BAR; PG8_SCHED;
            PG8_LDB(B0, 1, 0); PG8_LDB(B1, 1, 1); PG8_SCHED; PG8_LDA(At, 1, 0); PG8_STAGE(PG8_SA(0, 1), a2 + hstepA, voffA);
            PG8_WAIT_V(8); PG8_WAIT_L(0); PG8_BAR; PG8_MMA(0, 0, At, B0); PG8_MMA(0, 1, At, B1); PG8_BAR; PG8_SCHED;
            PG8_LDA(At, 1, 1); PG8_STAGE(PG8_SB(1, 0), b3, voffB); PG8_STAGE(PG8_SB(1, 1), b3 + hstep, voffB); PG8_STAGE(PG8_SA(1, 0), a3, voffA);
            PG8_WAIT_V(8); PG8_WAIT_L(0); PG8_BAR; PG8_MMA(1, 0, At, B0); PG8_MMA(1, 1, At, B1); PG8_BAR; PG8_SCHED;
            } else {
            PG8_LDB(B0, 0, 0); PG8_SCHED; PG8_LDA(At, 0, 0); PG8_STAGE(PG8_SA(1, 1), a1 + hstepA, voffA);
            PG8_WAIT_L(8); PG8_BAR; PG8_WAIT_L(0); PG8_MMA(0, 0, At, B0); PG8_BAR; PG8_SCHED;
            PG8_LDB(B1, 0, 1); PG8_STAGE(PG8_SB(0, 0), b2, voffB);
            PG8_BAR; PG8_WAIT_L(0); PG8_MMA(0, 1, At, B1); PG8_BAR;
            PG8_LDA(At, 0, 1); PG8_STAGE(PG8_SA(0, 0), a2, voffA);
            PG8_BAR; PG8_WAIT_L(0); PG8_MMA(1, 0, At, B0); PG8_BAR; PG8_SCHED;
            PG8_STAGE(PG8_SB(0, 1), b2 + hstep, voffB);
            PG8_WAIT_V(6); PG8_BAR; PG8_MMA(1, 1, At, B1); PG8_BAR;
            PG8_LDB(B0, 1, 0); PG8_SCHED; PG8_LDA(At, 1, 0); PG8_STAGE(PG8_SA(0, 1), a2 + hstepA, voffA);
            PG8_WAIT_L(8); PG8_BAR; PG8_WAIT_L(0); PG8_MMA(0, 0, At, B0); PG8_BAR; PG8_SCHED;
            PG8_LDB(B1, 1, 1); PG8_STAGE(PG8_SB(1, 0), b3, voffB);
            PG8_BAR; PG8_WAIT_L(0); PG8_MMA(0, 1, At, B1); PG8_BAR;
            PG8_LDA(At, 1, 1); PG8_STAGE(PG8_SA(1, 0), a3, voffA);
            PG8_BAR; PG8_WAIT_L(0); PG8_MMA(1, 0, At, B0); PG8_BAR; PG8_SCHED;
            PG8_STAGE(PG8_SB(1, 1), b3 + hstep, voffB);
            PG8_WAIT_V(6); PG8_BAR; PG8_MMA(1, 1, At, B1); PG8_BAR;
            }
        }
        if constexpr (ALIGN_EPI) { if (wr == 0) PG8_BAR; }
        if constexpr (F8) asm volatile("s_nop 15\n\ts_nop 15" ::: "memory");
        if constexpr (!Epi::AFTER_DRAIN) { E(acc, cur, wr, wc, fr, fq); S.done(cur); }
        if (!has_next) break;
#pragma unroll
        for (int a = 0; a < 2; ++a)
#pragma unroll
            for (int b = 0; b < 2; ++b)
#pragma unroll
                for (int m = 0; m < 4; ++m)
#pragma unroll
                    for (int n = 0; n < 2; ++n) acc[a][b][m][n] = (f32x4){0.f, 0.f, 0.f, 0.f};
        cur = nxt; cA = nA; cB = nB; ++ui;
        if constexpr (ALIGN_EPI) { if (wr == 1) PG8_BAR; }
    }
    PG8_WAIT_V(0);
    if constexpr (!ALIGN_EPI) { if (wr == 0) PG8_BAR; }
    PG8_BAR;
    if constexpr (Epi::AFTER_DRAIN) { E.fused(acc, cur, wr, wc, fr, fq, lds, wid, lane); S.done(cur); }
#undef PG8_SA
#undef PG8_SB
#undef PG8_STAGE
#undef PG8_LDA
#undef PG8_LDB
#undef PG8_MMA
#undef PG8_WAIT_V
#undef PG8_WAIT_L
#undef PG8_BAR
#undef PG8_SCHED
}
}

constexpr int T = 16384, NMETA = 16, LTOK = T + NMETA, LPAD = 16640;
constexpr int DM = 1024, INW = 1184, INWP = 1280;
constexpr int NKP = 16640;
constexpr int NEXP = 32, TOPK = 4, DFF = 1024, MAXTILES = 288, MAXSLOTS = MAXTILES * 256;
constexpr float NORM_EPS = 1e-6f, LOG2E = 1.4426950408889634f;
constexpr float QSCALE_SWA = 0.125f * LOG2E;
constexpr float QSCALE_MLA = 0.10206207261596577f * LOG2E;
enum { I_X = 0, I_META, I_ANG, I_WIN, I_SQG, I_SKG, I_SINK, I_QLG, I_WQUP, I_KVLG, I_WKVUP, I_MQG, I_MKG, I_WOUT, I_FNG, I_RW, I_RB, I_WG, I_BG, I_WU, I_BU, I_WD, I_BD, N_IN };

constexpr size_t MiB = 1u << 20;
constexpr size_t WS_CTL = 0, CTL_ZERO_BYTES = 1 * MiB;
constexpr size_t WS_WIN = 1 * MiB;
constexpr size_t WS_WOUT = 4 * MiB;
constexpr size_t WS_WQUP = 6 * MiB;
constexpr size_t WS_WKVUP = 6 * MiB + 512 * 1024;
constexpr size_t WS_ROPE = 7 * MiB;
constexpr size_t WS_TOPE = 9 * MiB + 256 * 1024;
constexpr size_t WS_TOPG = WS_TOPE + 256 * 1024;
constexpr size_t WS_TRANK = WS_TOPG + 256 * 1024;
constexpr size_t WS_TSLOT = WS_TRANK + 256 * 1024;
constexpr size_t WS_SGATE = WS_TSLOT + 256 * 1024;
constexpr size_t WS_CCNT = WS_SGATE + 320 * 1024;
constexpr size_t WS_ETOT = WS_CCNT + 32 * 1024;
constexpr size_t WS_RWH = WS_ETOT + 32 * 1024;
constexpr size_t WS_RWL = WS_RWH + 64 * 1024;
constexpr size_t WS_W1 = 11 * MiB;
constexpr size_t WS_W2 = 139 * MiB;
constexpr size_t WS_AR = 203 * MiB;
constexpr size_t WS_AN = WS_AR;
constexpr size_t WS_PROJ = WS_AR + 33 * MiB;
constexpr size_t WS_QS = WS_AR + 74 * MiB;
constexpr size_t WS_KS = WS_AR + 90 * MiB;
constexpr size_t WS_VS = WS_AR + 95 * MiB;
constexpr size_t WS_QL = WS_AR + 100 * MiB;
constexpr size_t WS_KVL = WS_AR + 108 * MiB;
constexpr size_t WS_KR = WS_AR + 113 * MiB;
constexpr size_t WS_QU = WS_AR + 116 * MiB;
constexpr size_t WS_KVU = WS_AR + 140 * MiB;
constexpr size_t WS_QM = WS_AR + 173 * MiB;
constexpr size_t WS_KM = WS_AR + 197 * MiB;
constexpr size_t WS_VM = WS_AR + 222 * MiB;
constexpr size_t WS_Y = WS_AR + 239 * MiB;
constexpr size_t WS_XS = WS_AR;
constexpr size_t WS_ACT = WS_AR + 144 * MiB;
constexpr size_t WS_YS = WS_XS;
constexpr size_t WS_H2B = WS_AR + 271 * MiB;
constexpr size_t WS_END = WS_AR + 303 * MiB;
static_assert(WS_END <= 512 * MiB, "workspace");
static_assert(WS_RWL + 64 * 1024 <= WS_W1 && WS_ROPE + (size_t)LTOK * 16 * 8 <= WS_TOPE, "small region");
static_assert(WS_Y + (size_t)T * DM * 2 <= WS_END && WS_VM + (size_t)8 * NKP * 64 * 2 <= WS_Y && WS_KM + (size_t)8 * NKP * 96 * 2 <= WS_VM, "arena");
constexpr int CW_BAR = 4096;

constexpr int RING_BYTES = 155648;
constexpr int MISC_OFF = RING_BYTES;
constexpr int LDS_BYTES = 163840;
constexpr int NWAVES = 8;

#define GAS __attribute__((address_space(1)))
#define LAS __attribute__((address_space(3)))
typedef unsigned short bf16_t;
typedef short bf16x8 __attribute__((ext_vector_type(8)));
typedef short s16x4 __attribute__((ext_vector_type(4)));
typedef float f32x4 __attribute__((ext_vector_type(4)));
typedef float f32x2 __attribute__((ext_vector_type(2)));
typedef float f32x16 __attribute__((ext_vector_type(16)));
typedef unsigned u32x4 __attribute__((ext_vector_type(4)));
typedef unsigned u32x2 __attribute__((ext_vector_type(2)));
#define LDS_WAIT() asm volatile("s_waitcnt lgkmcnt(0)" ::: "memory")
#define SBAR() __builtin_amdgcn_sched_barrier(0)
__device__ __forceinline__ unsigned pk2(float lo, float hi) { unsigned r; asm volatile("v_cvt_pk_bf16_f32 %0, %1, %2" : "=v"(r) : "v"(lo), "v"(hi)); return r; }
__device__ __forceinline__ float bflo(unsigned w) { return __uint_as_float(w << 16); }
__device__ __forceinline__ float bfhi(unsigned w) { return __uint_as_float(w & 0xffff0000u); }
__device__ __forceinline__ void unpack8(const u32x4 w, float (&v)[8]) { v[0] = bflo(w.x); v[1] = bfhi(w.x); v[2] = bflo(w.y); v[3] = bfhi(w.y); v[4] = bflo(w.z); v[5] = bfhi(w.z); v[6] = bflo(w.w); v[7] = bfhi(w.w); }
__device__ __forceinline__ float wave_sum(float v) {
#pragma unroll
    for (int o = 1; o < 64; o <<= 1) v += __shfl_xor(v, o);
    return v;
}
__device__ __forceinline__ float wave_max(float v) {
#pragma unroll
    for (int o = 1; o < 64; o <<= 1) v = fmaxf(v, __shfl_xor(v, o));
    return v;
}
__device__ __forceinline__ float rstd_of(float ss, float n) { return 1.0f / sqrtf(ss / n + NORM_EPS); }
__device__ __forceinline__ int crow(int r, int hi) { return (r & 3) + 8 * (r >> 2) + 4 * hi; }

__device__ __forceinline__ void tr_item(const float* __restrict__ W, int K, int N, int k0, int n0, int ncols, bf16_t* WT, size_t drow0, LAS float* scr, int lane, const float* kscale = nullptr) {
    const int lr = lane >> 4, lc = (lane & 15) * 4;
    f32x4 v[16];
    if (lc < ncols) {
#pragma unroll
        for (int i = 0; i < 16; ++i) { v[i] = *(const f32x4*)(W + (size_t)(k0 + i * 4 + lr) * N + n0 + lc); if (kscale) v[i] = v[i] * kscale[k0 + i * 4 + lr]; }
    } else {
#pragma unroll
        for (int i = 0; i < 16; ++i) v[i] = (f32x4){0.f, 0.f, 0.f, 0.f};
    }
#pragma unroll
    for (int i = 0; i < 16; ++i) { LAS float* s = scr + (i * 4 + lr) * 65 + lc; s[0] = v[i].x; s[1] = v[i].y; s[2] = v[i].z; s[3] = v[i].w; }
    LDS_WAIT(); asm volatile("" ::: "memory");
    const int c = lane >> 3, nn = lane & 7;
#pragma unroll
    for (int jj = 0; jj < 8; ++jj) { const int n = nn + 8 * jj; const LAS float* s = scr + (8 * c) * 65 + n;
        u32x4 o; o.x = pk2(s[0], s[65]); o.y = pk2(s[130], s[195]); o.z = pk2(s[260], s[325]); o.w = pk2(s[390], s[455]);
        if (n < ncols) *(u32x4*)(WT + (drow0 + n) * K + k0 + 8 * c) = o; }
    LDS_WAIT(); asm volatile("" ::: "memory");
}
__device__ __forceinline__ unsigned pk4_fp8w(float a, float b, float c, float d) { int w = 0; w = __builtin_amdgcn_cvt_pk_fp8_f32(a * 256.f, b * 256.f, w, false); w = __builtin_amdgcn_cvt_pk_fp8_f32(c * 256.f, d * 256.f, w, true); return (unsigned)w; }
__device__ __forceinline__ void tr_item8(const float* __restrict__ W, int K, int N, int k0, int n0, unsigned char* WT, size_t drow0, LAS float* scr, int lane) {
    const int lr = lane >> 3, lc = (lane & 7) * 4;
    f32x4 v[16];
#pragma unroll
    for (int i = 0; i < 16; ++i) v[i] = __builtin_nontemporal_load((const f32x4*)(W + (size_t)(k0 + i * 8 + lr) * N + n0 + lc));
#pragma unroll
    for (int i = 0; i < 16; ++i) { LAS float* s = scr + lc * 129 + i * 8 + lr; s[0] = v[i].x; s[129] = v[i].y; s[258] = v[i].z; s[387] = v[i].w; }
    LDS_WAIT(); asm volatile("" ::: "memory");
    const int n = lane & 31, c0 = lane >> 5;
#pragma unroll
    for (int jj = 0; jj < 4; ++jj) { const int c = c0 + 2 * jj; const LAS float* s = scr + n * 129 + 16 * c;
        u32x4 o; o.x = pk4_fp8w(s[0], s[1], s[2], s[3]); o.y = pk4_fp8w(s[4], s[5], s[6], s[7]); o.z = pk4_fp8w(s[8], s[9], s[10], s[11]); o.w = pk4_fp8w(s[12], s[13], s[14], s[15]);
        *(u32x4*)(WT + (drow0 + n) * K + k0 + 16 * c) = o; }
    LDS_WAIT(); asm volatile("" ::: "memory");
}
__device__ __forceinline__ void sincos_red(double x, float& c, float& s) {
    const double x2 = x * x;
    double sp = -1.0 / 51090942171709440000.0;
    sp = sp * x2 + 1.0 / 121645100408832000.0;
    sp = sp * x2 - 1.0 / 355687428096000.0;
    sp = sp * x2 + 1.0 / 1307674368000.0;
    sp = sp * x2 - 1.0 / 6227020800.0;
    sp = sp * x2 + 1.0 / 39916800.0;
    sp = sp * x2 - 1.0 / 362880.0;
    sp = sp * x2 + 1.0 / 5040.0;
    sp = sp * x2 - 1.0 / 120.0;
    sp = sp * x2 + 1.0 / 6.0;
    sp = sp * x2 * (-1.0) + 1.0;
    double cp = 1.0 / 1124000727777607680000.0;
    cp = cp * x2 - 1.0 / 2432902008176640000.0;
    cp = cp * x2 + 1.0 / 6402373705728000.0;
    cp = cp * x2 - 1.0 / 20922789888000.0;
    cp = cp * x2 + 1.0 / 87178291200.0;
    cp = cp * x2 - 1.0 / 479001600.0;
    cp = cp * x2 + 1.0 / 3628800.0;
    cp = cp * x2 - 1.0 / 40320.0;
    cp = cp * x2 + 1.0 / 720.0;
    cp = cp * x2 - 1.0 / 24.0;
    cp = cp * x2 + 0.5;
    cp = cp * x2 * (-1.0) + 1.0;
    s = (float)(x * sp); c = (float)cp;
}

#define XB_TMO      128
#define XB_XCNT(j)  (256  + 64 * (j))
#define XB_XSUB(j)  (1280 + 64 * (j))
#define XB_XGEN(j)  (2304 + 64 * (j))
#define XB_TOP      3328
#define XB_TOPGEN   3392
#define XCD_BAR_WORDS 3456
#define XB_SPIN_CAP (1u << 18)

__device__ __forceinline__ unsigned xb_ld(unsigned* p)              { return __hip_atomic_load(p, __ATOMIC_RELAXED, __HIP_MEMORY_SCOPE_AGENT); }
__device__ __forceinline__ unsigned xb_add(unsigned* p, unsigned v) { return __hip_atomic_fetch_add(p, v, __ATOMIC_RELAXED, __HIP_MEMORY_SCOPE_AGENT); }
__device__ __forceinline__ unsigned xb_xcc_id() { return (unsigned)__builtin_amdgcn_s_getreg((3 << 11) | 20) & 0xFu; }
#define XB_SPIN(cond, bar) do { unsigned _sp = 0; while (cond) { __builtin_amdgcn_s_sleep(1); \
    if ((++_sp & 255u) == 0u) { if (xb_ld(&(bar)[XB_TMO])) break; if (_sp > XB_SPIN_CAP) { atomicAdd(&(bar)[XB_TMO], 1u); break; } } } } while (0)

struct XcdBarrier {
    unsigned* bar; unsigned x;
    volatile LAS unsigned* st;
};

__device__ __forceinline__ XcdBarrier xcd_barrier_post(unsigned* bar, volatile LAS unsigned* st) {
    XcdBarrier b; b.bar = bar; b.x = xb_xcc_id(); b.st = st;
    if (threadIdx.x == 0) (void)xb_add(&bar[XB_XCNT(b.x)], 1u);
    return b;
}
__device__ __forceinline__ void xcd_barrier_complete(unsigned* bar, unsigned x, unsigned& nloc, unsigned& nx) {
    const unsigned G = gridDim.x * gridDim.y * gridDim.z;
    unsigned sum, cnt, mine, sp = 0u;
    for (;;) {
        sum = 0u; cnt = 0u; mine = 0u;
#pragma unroll
        for (unsigned j = 0; j < 16; ++j) { const unsigned c = xb_ld(&bar[XB_XCNT(j)]); sum += c; cnt += (c > 0u) ? 1u : 0u; mine = (j == x) ? c : mine; }
        if (sum == G) break;
        __builtin_amdgcn_s_sleep(1);
        if ((++sp & 255u) == 0u) { if (xb_ld(&bar[XB_TMO])) break; if (sp > XB_SPIN_CAP) { atomicAdd(&bar[XB_TMO], 1u); break; } }
    }
    nloc = mine > 0u ? mine : 1u; nx = cnt > 0u ? cnt : 1u;
}

__device__ __forceinline__ void xcd_barrier(const XcdBarrier& b) {
    asm volatile("s_waitcnt vmcnt(0)" ::: "memory");
    __syncthreads();
    if (threadIdx.x == 0) {
        unsigned* bar = b.bar;
        __builtin_amdgcn_s_waitcnt(0);
        unsigned nloc = b.st[0], nx = b.st[1];
        if (nloc == 0u) { xcd_barrier_complete(bar, b.x, nloc, nx); b.st[0] = nloc; b.st[1] = nx; }
        const unsigned old = xb_add(&bar[XB_XSUB(b.x)], 1u);
        const unsigned gen = old / nloc;
        if (old + 1u == (gen + 1u) * nloc) {
            __builtin_amdgcn_fence(__ATOMIC_RELEASE, "agent");
            asm volatile("s_waitcnt vmcnt(0)" ::: "memory");
            const unsigned og = xb_add(&bar[XB_TOP], 1u);
            const unsigned tg = og / nx;
            if (og + 1u == (tg + 1u) * nx) xb_add(&bar[XB_TOPGEN], 1u);
            else XB_SPIN(xb_ld(&bar[XB_TOPGEN]) == tg, bar);
            __builtin_amdgcn_fence(__ATOMIC_ACQUIRE, "agent");
            xb_add(&bar[XB_XGEN(b.x)], 1u);
            asm volatile("s_waitcnt vmcnt(0)" ::: "memory");
        } else {
            XB_SPIN(xb_ld(&bar[XB_XGEN(b.x)]) == gen, bar);
            __builtin_amdgcn_fence(__ATOMIC_ACQUIRE, "agent");
            asm volatile("s_waitcnt vmcnt(0)" ::: "memory");
        }
    }
    __syncthreads();
}

__device__ __forceinline__ size_t km_off(int h, int key, int d) { return ((size_t)h * (NKP / 64) + (key >> 6)) * 6144 + (d >> 4) * 1024 + (key & 63) * 16 + (d & 15); }
__device__ __forceinline__ unsigned pk2_fp8(float a, float b) { return (unsigned)__builtin_amdgcn_cvt_pk_fp8_f32(a, b, 0, false) & 0xffffu; }
__device__ __forceinline__ unsigned pk4_fp8s(float a, float b, float c, float d) { int w = 0; w = __builtin_amdgcn_cvt_pk_fp8_f32(a, b, w, false); w = __builtin_amdgcn_cvt_pk_fp8_f32(c, d, w, true); return (unsigned)w; }
__device__ __forceinline__ size_t vm_off(int h, int key, int c) { return ((size_t)h * (NKP / 64) + (key >> 6)) * 4096 + (c >> 5) * 2048 + ((key >> 4) & 3) * 512 + (key & 15) * 32 + (c & 31); }
struct P4In { f32x4 cs; u32x4 kn, wv, qn; u32x2 ql; unsigned kvl, kr1, kr2, w1, w2; };
__device__ __forceinline__ P4In p4_load(int r, int lane, const bf16_t* QU, const bf16_t* KVU, const bf16_t* PROJ, const float* ROPE) {
    const int h = lane >> 3, j = lane & 7; P4In x;
    x.cs = *(const f32x4*)(ROPE + ((size_t)r * 16 + 2 * j) * 2);
    const bf16_t* kp = KVU + (size_t)r * 1024 + h * 128; const bf16_t* pr = PROJ + (size_t)r * INWP;
    x.kn = *(const u32x4*)(kp + 8 * j); x.wv = *(const u32x4*)(kp + 64 + 8 * j);
    x.kvl = *(const unsigned*)(pr + 1024 + 2 * lane);
    x.kr1 = *(const unsigned*)(pr + 1152 + 2 * j); x.kr2 = *(const unsigned*)(pr + 1168 + 2 * j);
    x.qn = (u32x4){0u, 0u, 0u, 0u}; x.w1 = 0u; x.w2 = 0u; x.ql = (u32x2){0u, 0u};
    if (r < T) { const bf16_t* qp = QU + (size_t)r * 768 + h * 96; x.qn = *(const u32x4*)(qp + 8 * j); x.w1 = *(const unsigned*)(qp + 64 + 2 * j); x.w2 = *(const unsigned*)(qp + 80 + 2 * j);
                 x.ql = *(const u32x2*)(pr + 768 + 4 * lane); }
    return x;
}
__device__ __forceinline__ void p4_token(int r, int lane, const P4In& x, const float* mqg, const float* mkg, bf16_t* QM, bf16_t* KM, bf16_t* VM) {
    const int h = lane >> 3, j = lane & 7;
    const f32x4 cs = x.cs;
    {
        const float a0 = bflo(x.kvl), a1 = bfhi(x.kvl);
        const float rkv = rstd_of(wave_sum(a0 * a0 + a1 * a1), 128.f);
        float kn[8]; unpack8(x.kn, kn);
#pragma unroll
        for (int i = 0; i < 8; ++i) kn[i] *= rkv;
        const float x1x = bflo(x.kr1), x1y = bfhi(x.kr1), x2x = bflo(x.kr2), x2y = bfhi(x.kr2);
        float ss = x1x * x1x + x1y * x1y + x2x * x2x + x2y * x2y;
#pragma unroll
        for (int i = 0; i < 8; ++i) ss += kn[i] * kn[i];
        ss += __shfl_xor(ss, 1); ss += __shfl_xor(ss, 2); ss += __shfl_xor(ss, 4);
        const float rs = rstd_of(ss, 96.f); const float* g = mkg + 8 * j;
        const float rk = rs * 4.0f;
        u32x2 o; o.x = pk4_fp8s(kn[0] * rk * g[0], kn[1] * rk * g[1], kn[2] * rk * g[2], kn[3] * rk * g[3]); o.y = pk4_fp8s(kn[4] * rk * g[4], kn[5] * rk * g[5], kn[6] * rk * g[6], kn[7] * rk * g[7]);
        const float y10 = x1x * rk * mkg[64 + 2 * j], y11 = x1y * rk * mkg[65 + 2 * j], y20 = x2x * rk * mkg[80 + 2 * j], y21 = x2y * rk * mkg[81 + 2 * j];
        unsigned char* K8 = (unsigned char*)KM;
        *(u32x2*)(K8 + km_off(h, r, 8 * j)) = o;
        *(unsigned short*)(K8 + km_off(h, r, 64 + 2 * j)) = (unsigned short)pk2_fp8(y10 * cs.x - y20 * cs.y, y11 * cs.z - y21 * cs.w);
        *(unsigned short*)(K8 + km_off(h, r, 80 + 2 * j)) = (unsigned short)pk2_fp8(y10 * cs.y + y20 * cs.x, y11 * cs.w + y21 * cs.z);
        float vv[8]; unpack8(x.wv, vv);
        u32x4 ov; ov.x = pk2(vv[0] * rkv, vv[1] * rkv); ov.y = pk2(vv[2] * rkv, vv[3] * rkv); ov.z = pk2(vv[4] * rkv, vv[5] * rkv); ov.w = pk2(vv[6] * rkv, vv[7] * rkv);
        *(u32x4*)(VM + vm_off(h, r, 8 * j)) = ov;
    }
    if (r < T) {
        const float b0 = bflo(x.ql.x), b1 = bfhi(x.ql.x), b2 = bflo(x.ql.y), b3 = bfhi(x.ql.y);
        const float rq = rstd_of(wave_sum((b0 * b0 + b1 * b1) + (b2 * b2 + b3 * b3)), 256.f);
        float qn[8]; unpack8(x.qn, qn);
#pragma unroll
        for (int i = 0; i < 8; ++i) qn[i] *= rq;
        const float x10 = bflo(x.w1) * rq, x11 = bfhi(x.w1) * rq, x20 = bflo(x.w2) * rq, x21 = bfhi(x.w2) * rq;
        float ss = x10 * x10 + x11 * x11 + x20 * x20 + x21 * x21;
#pragma unroll
        for (int i = 0; i < 8; ++i) ss += qn[i] * qn[i];
        ss += __shfl_xor(ss, 1); ss += __shfl_xor(ss, 2); ss += __shfl_xor(ss, 4);
        const float rs = rstd_of(ss, 96.f) * (QSCALE_MLA * 16.0f); const float* g = mqg + 8 * j;
        u32x2 o; o.x = pk4_fp8s(qn[0] * rs * g[0], qn[1] * rs * g[1], qn[2] * rs * g[2], qn[3] * rs * g[3]); o.y = pk4_fp8s(qn[4] * rs * g[4], qn[5] * rs * g[5], qn[6] * rs * g[6], qn[7] * rs * g[7]);
        const float y10 = x10 * rs * mqg[64 + 2 * j], y11 = x11 * rs * mqg[65 + 2 * j], y20 = x20 * rs * mqg[80 + 2 * j], y21 = x21 * rs * mqg[81 + 2 * j];
        unsigned char* qo = (unsigned char*)QM + ((size_t)h * T + r) * 128;
        *(u32x2*)(qo + 8 * j) = o;
        *(unsigned short*)(qo + 64 + 2 * j) = (unsigned short)pk2_fp8(y10 * cs.x - y20 * cs.y, y11 * cs.z - y21 * cs.w);
        *(unsigned short*)(qo + 80 + 2 * j) = (unsigned short)pk2_fp8(y10 * cs.y + y20 * cs.x, y11 * cs.w + y21 * cs.z);
        *(unsigned*)(qo + 96 + 4 * j) = 0u;
    }
}

__device__ __forceinline__ int v_st16(int k, int c) { const int kk = (k & ~0xC) | ((k & 4) << 1) | ((k & 8) >> 1); return ((kk >> 3) * 2 + (c >> 5)) * 512 + ((kk & 7) * 32 + (c & 31)) * 2; }
__device__ __forceinline__ int v_rd_base(int lane) { return ((lane & 3) << 3) | (((lane >> 2) & 3) << 6) | (((lane >> 4) & 1) << 5) | (((lane >> 5) & 1) << 8); }
constexpr int v_rd_off(int d0, int ks, int half) { return d0 * 512 + ks * 2048 + half * 1024; }
template <int OFF> __device__ __forceinline__ s16x4 tr_read(int vb) { s16x4 r; asm volatile("ds_read_b64_tr_b16 %0, %1 offset:%2" : "=&v"(r) : "v"(vb), "i"(OFF) : "memory"); return r; }
#define PKV(L, H) (bf16x8){L[0], L[1], L[2], L[3], H[0], H[1], H[2], H[3]}
#define PK4(P, BASE, OUT) do { unsigned a0_ = pk2(P[BASE + 0], P[BASE + 1]), a1_ = pk2(P[BASE + 2], P[BASE + 3]);   \
    unsigned b0_ = pk2(P[BASE + 4], P[BASE + 5]), b1_ = pk2(P[BASE + 6], P[BASE + 7]);                              \
    auto r0_ = __builtin_amdgcn_permlane32_swap(a0_, b0_, false, false); auto r1_ = __builtin_amdgcn_permlane32_swap(a1_, b1_, false, false); \
    u32x4 w_ = {r0_[0], r1_[0], r0_[1], r1_[1]}; OUT = __builtin_bit_cast(bf16x8, w_); } while (0)
template <int D0> __device__ __forceinline__ void pv4(f32x16& od, int vb, bf16x8 pa0, bf16x8 pa1, bf16x8 pa2, bf16x8 pa3) {
    const s16x4 l0 = tr_read<v_rd_off(D0, 0, 0)>(vb), h0 = tr_read<v_rd_off(D0, 0, 1)>(vb), l1 = tr_read<v_rd_off(D0, 1, 0)>(vb), h1 = tr_read<v_rd_off(D0, 1, 1)>(vb);
    const s16x4 l2 = tr_read<v_rd_off(D0, 2, 0)>(vb), h2 = tr_read<v_rd_off(D0, 2, 1)>(vb), l3 = tr_read<v_rd_off(D0, 3, 0)>(vb), h3 = tr_read<v_rd_off(D0, 3, 1)>(vb);
    asm volatile("s_waitcnt lgkmcnt(0)" ::: "memory"); SBAR();
    od = __builtin_amdgcn_mfma_f32_32x32x16_bf16(pa0, PKV(l0, h0), od, 0, 0, 0);
    od = __builtin_amdgcn_mfma_f32_32x32x16_bf16(pa1, PKV(l1, h1), od, 0, 0, 0);
    od = __builtin_amdgcn_mfma_f32_32x32x16_bf16(pa2, PKV(l2, h2), od, 0, 0, 0);
    od = __builtin_amdgcn_mfma_f32_32x32x16_bf16(pa3, PKV(l3, h3), od, 0, 0, 0);
}
template <int D0> __device__ __forceinline__ void pv2(f32x16& od, int vb, bf16x8 pa0, bf16x8 pa1) {
    const s16x4 l0 = tr_read<v_rd_off(D0, 0, 0)>(vb), h0 = tr_read<v_rd_off(D0, 0, 1)>(vb), l1 = tr_read<v_rd_off(D0, 1, 0)>(vb), h1 = tr_read<v_rd_off(D0, 1, 1)>(vb);
    asm volatile("s_waitcnt lgkmcnt(0)" ::: "memory"); SBAR();
    od = __builtin_amdgcn_mfma_f32_32x32x16_bf16(pa0, PKV(l0, h0), od, 0, 0, 0);
    od = __builtin_amdgcn_mfma_f32_32x32x16_bf16(pa1, PKV(l1, h1), od, 0, 0, 0);
}

constexpr float YSC = 32.0f;
__device__ __forceinline__ void y8_put(unsigned char* p, float a, float b) {
    const unsigned w = (unsigned)__builtin_amdgcn_cvt_pk_fp8_f32(__builtin_amdgcn_fmed3f(a, -448.f, 448.f), __builtin_amdgcn_fmed3f(b, -448.f, 448.f), 0, false);
    p[0] = (unsigned char)w; p[32] = (unsigned char)(w >> 8);
}
constexpr int SWA_ROWS = 416, SWA_K_BYTES = SWA_ROWS * 128, SWA_SCR = 2 * SWA_K_BYTES;
__device__ __forceinline__ void swa_item(int qb, int kvh, const bf16_t* PROJ, const float* sqg, const float* skg, bf16_t* Y, const float* sink, float bound2, LAS unsigned char* lds, int tid) {
    const int lane = tid & 63, wid = __builtin_amdgcn_readfirstlane(tid >> 6), r32 = lane & 31, hi = lane >> 5;
    constexpr int NPASS = (SWA_ROWS * 8 + NWAVES * 64 - 1) / (NWAVES * 64);
    u32x4 kdv[NPASS], vdv[NPASS];
#pragma unroll
    for (int it = 0; it < NPASS; ++it) {
        const int ch = tid + it * (NWAVES * 64), kl = ch >> 3, c8 = ch & 7;
        int row = -1;
        if (ch < SWA_ROWS * 8) { if (kl < 16) row = T + kl; else if (kl >= 32) { const int key = 128 * (qb - 1) + (kl - 32); if (key >= 0 && key < T) row = key; } }
        kdv[it] = (u32x4){0u, 0u, 0u, 0u}; vdv[it] = kdv[it];
        if (row >= 0) { kdv[it] = *(const u32x4*)(PROJ + (size_t)row * INWP + 512 + kvh * 64 + c8 * 8); vdv[it] = *(const u32x4*)(PROJ + (size_t)row * INWP + 640 + kvh * 64 + c8 * 8); }
    }
#pragma unroll
    for (int it = 0; it < NPASS; ++it) {
        const int ch = tid + it * (NWAVES * 64), kl = ch >> 3, c8 = ch & 7;
        if (ch < SWA_ROWS * 8) {
            u32x4 kd = kdv[it];
            {
                float v[8]; unpack8(kd, v); float ss = 0.f;
#pragma unroll
                for (int i = 0; i < 8; ++i) ss += v[i] * v[i];
                ss += __shfl_xor(ss, 1); ss += __shfl_xor(ss, 2); ss += __shfl_xor(ss, 4);
                const float rs = rstd_of(ss, 64.f); const float* g = skg + c8 * 8;
                kd.x = pk2(v[0] * rs * g[0], v[1] * rs * g[1]); kd.y = pk2(v[2] * rs * g[2], v[3] * rs * g[3]); kd.z = pk2(v[4] * rs * g[4], v[5] * rs * g[5]); kd.w = pk2(v[6] * rs * g[6], v[7] * rs * g[7]); }
            *(LAS u32x4*)(lds + kl * 128 + ((c8 ^ ((kl >> 1) & 7)) << 4)) = kd;
            *(LAS u32x4*)(lds + SWA_K_BYTES + (kl >> 4) * 2048 + v_st16(kl & 15, c8 * 8)) = vdv[it];
        }
    }
    __syncthreads();
    const int hq = kvh * 4 + (wid >> 1);
    const float slope2 = exp2f(-(float)(hq + 1)) * LOG2E, sinkv = sink[hq] * LOG2E;
    const float Mh = fmaxf(bound2, sinkv);
    LAS float* li = (LAS float*)(lds + SWA_SCR) + wid * 64;
    const int vbase = (int)(uintptr_t)(lds + SWA_K_BYTES) + v_rd_base(lane);
#pragma unroll 1
    for (int sb = 0; sb < 2; ++sb) {
        const int rb = (wid & 1) * 2 + sb, r0 = qb * 128 + rb * 32, row = r0 + r32;
        bf16x8 qr[4];
#pragma unroll
        for (int d0 = 0; d0 < 4; ++d0) qr[d0] = *(const bf16x8*)(PROJ + (size_t)row * INWP + hq * 64 + d0 * 16 + hi * 8);
        {
            float ss = 0.f; float qv[4][8];
#pragma unroll
            for (int d0 = 0; d0 < 4; ++d0) { unpack8(__builtin_bit_cast(u32x4, qr[d0]), qv[d0]);
#pragma unroll
                for (int i = 0; i < 8; ++i) ss += qv[d0][i] * qv[d0][i]; }
            ss += __shfl_xor(ss, 32);
            const float rs = rstd_of(ss, 64.f) * QSCALE_SWA;
#pragma unroll
            for (int d0 = 0; d0 < 4; ++d0) { const float* g = sqg + d0 * 16 + hi * 8;
                const u32x4 w = (u32x4){pk2(qv[d0][0] * rs * g[0], qv[d0][1] * rs * g[1]), pk2(qv[d0][2] * rs * g[2], qv[d0][3] * rs * g[3]), pk2(qv[d0][4] * rs * g[4], qv[d0][5] * rs * g[5]), pk2(qv[d0][6] * rs * g[6], qv[d0][7] * rs * g[7])};
                qr[d0] = __builtin_bit_cast(bf16x8, w); } }
        f32x16 o0 = {}, o1 = {}; float lsum = 0.f;
        const float flo = fmaxf(-128.f, (float)(-row)), fhi = fminf(128.f, (float)(T - 1 - row));
#pragma unroll 2
        for (int tt = 0; tt < 10; ++tt) {
            const int tl = (tt == 0) ? 0 : rb + tt;
            const int kl = tl * 32 + r32;
            f32x16 p;
#pragma unroll
            for (int r = 0; r < 16; ++r) p[r] = -Mh;
            const LAS unsigned char* kp = lds + kl * 128; const int sw = (kl >> 1) & 7;
#pragma unroll
            for (int d0 = 0; d0 < 4; ++d0) { const bf16x8 a = *(const LAS bf16x8*)(kp + (((d0 * 2 + hi) ^ sw) << 4)); p = __builtin_amdgcn_mfma_f32_32x32x16_bf16(a, qr[d0], p, 0, 0, 0); }
            const float fbase = (float)(128 * (qb - 1) + 32 * (tl - 1) - row);
#pragma unroll
            for (int r = 0; r < 16; ++r) {
                const int kk = crow(r, hi);
                if (tt == 0) { p[r] = (kk < 16) ? __builtin_amdgcn_exp2f(p[r]) : 0.f; }
                else { const float fd = fbase + (float)kk;
                    const float sv = __builtin_fmaf(-slope2, __builtin_fabsf(fd), p[r]);
                    p[r] = (fd >= flo && fd <= fhi) ? __builtin_amdgcn_exp2f(sv) : 0.f; }
            }
#pragma unroll
            for (int r = 0; r < 16; ++r) lsum += p[r];
            bf16x8 pa0, pa1; PK4(p, 0, pa0); PK4(p, 8, pa1);
            const int vb = vbase + tl * 4096;
            pv2<0>(o0, vb, pa0, pa1); pv2<1>(o1, vb, pa0, pa1);
        }
        { auto rr = __builtin_amdgcn_permlane32_swap(__float_as_uint(lsum), __float_as_uint(lsum), false, false); lsum = __uint_as_float(rr[0]) + __uint_as_float(rr[1]); }
        lsum += __builtin_amdgcn_exp2f(sinkv - Mh);
        if (hi == 0) li[r32] = lsum;
        LDS_WAIT(); asm volatile("" ::: "memory");
        unsigned char* yo = (unsigned char*)Y + (size_t)r0 * DM + hq * 64 + r32;
#pragma unroll
        for (int r = 0; r < 16; ++r) { const int orow = crow(r, hi); const float rl = __builtin_amdgcn_rcpf(li[orow]) * YSC;
            y8_put(yo + (size_t)orow * DM, o0[r] * rl, o1[r] * rl); }
        LDS_WAIT(); asm volatile("" ::: "memory");
    }
    __syncthreads();
}

constexpr int MLA_SLOT = 8192 + 8192, MLA_NS = 5, MLA_SCR = MLA_NS * MLA_SLOT;
__device__ __forceinline__ void glds16(const void* gsrc, unsigned lds_dst) { unsigned keep;
    asm volatile("s_mov_b32 %0, m0\n\ts_mov_b32 m0, %2\n\ts_nop 0\n\tglobal_load_lds_dwordx4 %1, off\n\ts_mov_b32 m0, %0" : "=&s"(keep) : "v"(gsrc), "s"(lds_dst) : "memory"); }
typedef short v4i16_t __attribute__((ext_vector_type(4)));
__device__ __forceinline__ s16x4 vtr(const LAS unsigned char* p) { return __builtin_bit_cast(s16x4, __builtin_amdgcn_ds_read_tr16_b64_v4i16((LAS v4i16_t*)p)); }
typedef int i32x8m __attribute__((ext_vector_type(8)));
typedef int i32x4m __attribute__((ext_vector_type(4)));
__device__ __forceinline__ void mla_kload(i32x8m (&kf)[4], const LAS unsigned char* kp) {
#pragma unroll
    for (int g = 0; g < 2; ++g)
#pragma unroll
        for (int sx = 0; sx < 2; ++sx) { kf[2 * g + sx].lo = *(const LAS i32x4m*)(kp + sx * 4096 + g * 512); kf[2 * g + sx].hi = *(const LAS i32x4m*)(kp + sx * 4096 + g * 512 + 1024); }
}
template <int H> __device__ __forceinline__ void mla_vload_h(s16x4 (&vf)[16], const LAS unsigned char* vp) {
#pragma unroll
    for (int i = 8 * H; i < 8 * H + 8; ++i) vf[i] = vtr(vp + (i >> 1) * 1024 + (i & 1) * 512);
}
__device__ __forceinline__ void mla_vload(s16x4 (&vf)[16], const LAS unsigned char* vp) {
#pragma unroll
    for (int i = 0; i < 16; ++i) vf[i] = vtr(vp + (i >> 1) * 1024 + (i & 1) * 512);
}
__device__ __forceinline__ void mla_qkt(f32x16& p0, f32x16& p1, const i32x8m (&kf)[4], const i32x8m (&qr)[2]) {
    const unsigned sa = 0x7d7d7d7du, sb = 0x7b7b7b7bu;
    asm volatile("v_mfma_scale_f32_32x32x64_f8f6f4 %0, %1, %2, 0, %3, %4 op_sel_hi:[0,0,0]" : "=&v"(p0) : "v"(kf[0]), "v"(qr[0]), "v"(sa), "v"(sb));
    asm volatile("v_mfma_scale_f32_32x32x64_f8f6f4 %0, %1, %2, 0, %3, %4 op_sel_hi:[0,0,0]" : "=&v"(p1) : "v"(kf[2]), "v"(qr[0]), "v"(sa), "v"(sb));
    asm volatile("v_mfma_scale_f32_32x32x64_f8f6f4 %0, %1, %2, %0, %3, %4 op_sel_hi:[0,0,0]" : "+v"(p0) : "v"(kf[1]), "v"(qr[1]), "v"(sa), "v"(sb));
    asm volatile("v_mfma_scale_f32_32x32x64_f8f6f4 %0, %1, %2, %0, %3, %4 op_sel_hi:[0,0,0]" : "+v"(p1) : "v"(kf[3]), "v"(qr[1]), "v"(sa), "v"(sb));
}
__device__ __forceinline__ void mla_pv(f32x16& o0, f32x16& o1, const s16x4 (&vf)[16], bf16x8 pa0, bf16x8 pa1, bf16x8 pa2, bf16x8 pa3) {
    o0 = __builtin_amdgcn_mfma_f32_32x32x16_bf16(pa0, PKV(vf[0], vf[1]), o0, 0, 0, 0);
    o1 = __builtin_amdgcn_mfma_f32_32x32x16_bf16(pa0, PKV(vf[8], vf[9]), o1, 0, 0, 0);
    o0 = __builtin_amdgcn_mfma_f32_32x32x16_bf16(pa1, PKV(vf[2], vf[3]), o0, 0, 0, 0);
    o1 = __builtin_amdgcn_mfma_f32_32x32x16_bf16(pa1, PKV(vf[10], vf[11]), o1, 0, 0, 0);
    o0 = __builtin_amdgcn_mfma_f32_32x32x16_bf16(pa2, PKV(vf[4], vf[5]), o0, 0, 0, 0);
    o1 = __builtin_amdgcn_mfma_f32_32x32x16_bf16(pa2, PKV(vf[12], vf[13]), o1, 0, 0, 0);
    o0 = __builtin_amdgcn_mfma_f32_32x32x16_bf16(pa3, PKV(vf[6], vf[7]), o0, 0, 0, 0);
    o1 = __builtin_amdgcn_mfma_f32_32x32x16_bf16(pa3, PKV(vf[14], vf[15]), o1, 0, 0, 0);
}
__device__ __forceinline__ void mla_exp(f32x16& p) {
#pragma unroll
    for (int r = 0; r < 16; ++r) p[r] = __builtin_amdgcn_exp2f(p[r]);
}
#define PKO(P, B) __builtin_bit_cast(bf16x8, (u32x4){pk2(P[B], P[B + 1]), pk2(P[B + 2], P[B + 3]), pk2(P[B + 4], P[B + 5]), pk2(P[B + 6], P[B + 7])})
__device__ __forceinline__ void mla_finish(f32x16& p0, f32x16& p1, float& l_reg, bf16x8& pa0, bf16x8& pa1, bf16x8& pa2, bf16x8& pa3) {
    mla_exp(p1);
    float ps = 0.f;
#pragma unroll
    for (int r = 0; r < 16; ++r) ps += p0[r];
#pragma unroll
    for (int r = 0; r < 16; ++r) ps += p1[r];
    l_reg += ps;
    pa0 = PKO(p0, 0); pa1 = PKO(p0, 8); pa2 = PKO(p1, 0); pa3 = PKO(p1, 8);
}
constexpr int CONV_NCI = 12, CONV_PITCH = 132, CONV_TILE = 32 * 144;
static_assert(MLA_SCR + 2048 + NWAVES * CONV_TILE + NWAVES * 4096 <= RING_BYTES, "MLA ring + row-sum scratch + conversion tiles + staging must stay below the LDS control words");
struct ConvSt { int ci, ct; bool act; const float* wsrc; unsigned char* wdst; int item0; u32x4 rd; };
__device__ __forceinline__ void conv_setup(ConvSt& c, const float* wg, const float* wu, const float* wd, unsigned char* W1F8, unsigned char* W2F8) {
    const int item = c.item0 + c.ci, mat = item >> 8, which = mat >> 5, e = mat & 31, rr = item & 255, kb = rr >> 5, nb = rr & 31, n0 = nb * 32, k0 = kb * 128;
    const float* W = (which == 0 ? wg : which == 1 ? wu : wd) + (size_t)e * 1024 * 1024;
    c.wsrc = W + (size_t)k0 * 1024 + n0;
    c.wdst = which < 2 ? W1F8 + ((size_t)e * 2048 + (n0 >> 7) * 256 + which * 128 + (n0 & 127)) * 1024 + k0 : W2F8 + ((size_t)e * 1024 + n0) * 1024 + k0;
}
__device__ __forceinline__ void conv_pre(ConvSt& c, unsigned ld_off, unsigned st_off, unsigned stg_lds) {
    if (c.act) {
        if (c.ct < 8) { const float* b0 = c.wsrc + (size_t)c.ct * 16 * 1024; const float* b1 = b0 + 8 * 1024; const unsigned d0 = stg_lds + (c.ct & 1) * 2048, d1 = d0 + 1024; unsigned keep;
            asm volatile("s_nop 4\n\ts_mov_b32 %0, m0\n\ts_mov_b32 m0, %2\n\ts_nop 0\n\tglobal_load_lds_dwordx4 %1, %3 nt\n\ts_mov_b32 m0, %4\n\ts_nop 0\n\tglobal_load_lds_dwordx4 %1, %5 nt\n\ts_mov_b32 m0, %0"
                         : "=&s"(keep) : "v"(ld_off), "s"(d0), "s"(b0), "s"(d1), "s"(b1) : "memory"); }
        else if (c.ct >= 9) { unsigned char* b = c.wdst + (c.ct - 9) * 32;
            asm volatile("s_nop 4\n\tglobal_store_dwordx4 %0, %1, %2\n\ts_nop 1" :: "v"(st_off), "v"(c.rd), "s"(b) : "memory"); }
    }
}
template <class F> __device__ __forceinline__ void conv_post(ConvSt& c, LAS unsigned char* wr_base, const LAS unsigned char* rd_base, const LAS unsigned char* stg, F&& setup) {
    if (c.act) {
        if (c.ct >= 1 && c.ct <= 8) {
            const LAS unsigned char* sp = stg + ((c.ct - 1) & 1) * 2048;
            const f32x4 x0 = *(const LAS f32x4*)sp, x1 = *(const LAS f32x4*)(sp + 1024);
            const unsigned p0 = pk4_fp8w(x0.x, x0.y, x0.z, x0.w), p1 = pk4_fp8w(x1.x, x1.y, x1.z, x1.w);
            LAS unsigned char* w = wr_base + 16 * (c.ct - 1);
            w[0] = (unsigned char)p0; w[CONV_PITCH] = (unsigned char)(p0 >> 8); w[2 * CONV_PITCH] = (unsigned char)(p0 >> 16); w[3 * CONV_PITCH] = (unsigned char)(p0 >> 24);
            w[8] = (unsigned char)p1; w[CONV_PITCH + 8] = (unsigned char)(p1 >> 8); w[2 * CONV_PITCH + 8] = (unsigned char)(p1 >> 16); w[3 * CONV_PITCH + 8] = (unsigned char)(p1 >> 24); }
        if (c.ct >= 8 && c.ct <= 11) { const LAS unsigned* r4 = (const LAS unsigned*)(rd_base + 32 * (c.ct - 8)); c.rd = (u32x4){r4[0], r4[1], r4[2], r4[3]}; }
        ++c.ct;
        if (c.ct == 13) { c.ct = 0; ++c.ci; c.act = c.ci < CONV_NCI; if (c.act) setup(); }
    }
}
#ifndef MLA_ILV
#define MLA_ILV 1
#endif
template <bool RIDER, class F> __device__ __forceinline__ void mla_unit(int h, int q0, const bf16_t* QM, const bf16_t* KM, const bf16_t* VM, bf16_t* Y, LAS unsigned char* lds, int tid, ConvSt& cv, F&& cvsetup) {
    const int lane = tid & 63, wid = __builtin_amdgcn_readfirstlane(tid >> 6), r32 = lane & 31, hi = lane >> 5;
    const unsigned char* Kh = (const unsigned char*)KM + (size_t)h * (NKP / 64) * 6144; const bf16_t* Vh = VM + (size_t)h * (NKP / 64) * 4096;
    LAS float* li = (LAS float*)(lds + MLA_SCR) + wid * 64;
    const unsigned lds0 = (unsigned)(uintptr_t)lds;
    for (int idx = tid; idx < MLA_NS * 128; idx += NWAVES * 64) *(LAS u32x4*)(lds + (idx >> 7) * MLA_SLOT + 6144 + (idx & 127) * 16) = (u32x4){0u, 0u, 0u, 0u};
    constexpr bool two = true;
    const int kch = wid < 6 ? wid : wid - 6;
    const unsigned char* ksrc = Kh + kch * 1024 + lane * 16;
    const bf16_t* vsrc = Vh + wid * 512 + lane * 8;
    const unsigned kdst = lds0 + kch * 1024, vdst = lds0 + 8192 + wid * 1024;
#define MLA_DMA(t, slot) do { if (two) glds16(ksrc + (size_t)(t) * 6144, (unsigned)__builtin_amdgcn_readfirstlane(kdst + (slot))); \
        glds16(vsrc + (size_t)(t) * 4096, (unsigned)__builtin_amdgcn_readfirstlane(vdst + (slot))); } while (0)
#define MLA_WAITBAR() do { if (two) asm volatile("s_waitcnt vmcnt(2) lgkmcnt(0)\n\ts_barrier" ::: "memory"); else asm volatile("s_waitcnt vmcnt(1) lgkmcnt(0)\n\ts_barrier" ::: "memory"); } while (0)
    const unsigned cv_ld = (unsigned)(((lane >> 3) * 1024 + (lane & 7) * 4) * 4), cv_st = (unsigned)((lane & 31) * 1024 + 16 * (lane >> 5));
    LAS unsigned char* cv_tile = lds + MLA_SCR + 2048 + wid * CONV_TILE;
    LAS unsigned char* cv_wr = cv_tile + (lane & 7) * 4 * CONV_PITCH + (lane >> 3); const LAS unsigned char* cv_rd = cv_tile + (lane & 31) * CONV_PITCH + 16 * (lane >> 5);
    const unsigned cv_stg = lds0 + MLA_SCR + 2048 + NWAVES * CONV_TILE + wid * 4096; const LAS unsigned char* cv_stgp = lds + MLA_SCR + 2048 + NWAVES * CONV_TILE + wid * 4096 + lane * 16;
    MLA_DMA(0, 0); MLA_DMA(1, MLA_SLOT);
    i32x8m qr[2];
    { const unsigned char* Qw = (const unsigned char*)QM + ((size_t)h * T + q0 + wid * 32 + r32) * 128 + hi * 32;
#pragma unroll
      for (int sx = 0; sx < 2; ++sx) { qr[sx].lo = *(const i32x4m*)(Qw + sx * 64); qr[sx].hi = *(const i32x4m*)(Qw + sx * 64 + 16); } }
    const LAS unsigned char* kp0 = lds + hi * 2048 + r32 * 16;
    const LAS unsigned char* vp0 = lds + 8192 + v_rd_base(lane);
    float l_reg = 0.f; f32x16 o0 = {}, o1 = {};
    f32x16 pA0, pA1, pB0, pB1; bf16x8 pa0, pa1, pa2, pa3; i32x8m kf[4];
#if MLA_ILV
    s16x4 vf[8];
#else
    s16x4 vf[16];
#endif
    MLA_WAITBAR();
    MLA_DMA(2, 2 * MLA_SLOT);
    mla_kload(kf, kp0);
    mla_qkt(pA0, pA1, kf, qr); asm volatile("s_nop 15\n\ts_nop 15\n\ts_nop 15\n\ts_nop 15\n\ts_nop 15" : "+v"(pA0), "+v"(pA1)); mla_exp(pA0);
    MLA_WAITBAR();
    MLA_DMA(3, 3 * MLA_SLOT);
    mla_kload(kf, kp0 + MLA_SLOT);
    int sl_prev = 0, sl_next = 2 * MLA_SLOT, sl_dma = 4 * MLA_SLOT;
#define MLA_ROT() do { sl_prev = (sl_prev == 4 * MLA_SLOT) ? 0 : sl_prev + MLA_SLOT; sl_next = (sl_next == 4 * MLA_SLOT) ? 0 : sl_next + MLA_SLOT; sl_dma = (sl_dma == 4 * MLA_SLOT) ? 0 : sl_dma + MLA_SLOT; } while (0)
    constexpr bool stag = false;
#if MLA_ILV
    const unsigned sa_ = 0x7d7d7d7du, sb_ = 0x7b7b7b7bu;
    float l_b = 0.f, l_c = 0.f, l_d = 0.f;
#pragma unroll
    for (int r = 0; r < 16; ++r) l_reg += pA0[r];
#define MLA_QK0(P, KF, QR) asm volatile("v_mfma_scale_f32_32x32x64_f8f6f4 %0, %1, %2, 0, %3, %4 op_sel_hi:[0,0,0]" : "=&v"(P) : "v"(KF), "v"(QR), "v"(sa_), "v"(sb_))
#define MLA_QK1(P, KF, QR) asm volatile("v_mfma_scale_f32_32x32x64_f8f6f4 %0, %1, %2, %0, %3, %4 op_sel_hi:[0,0,0]" : "+v"(P) : "v"(KF), "v"(QR), "v"(sa_), "v"(sb_))
#define MLA_EXPN(P, a, b) do { _Pragma("unroll") for (int r_ = (a); r_ < (b); ++r_) { float x_ = P[r_]; asm volatile("v_exp_f32_e32 %0, %0" : "+v"(x_)); P[r_] = x_; } } while (0)
#define MLA_ADDN(P, a, b) do { _Pragma("unroll") for (int r_ = (a); r_ < (b); ++r_) { const float x_ = P[r_]; \
        if ((r_ & 3) == 0) asm volatile("v_add_f32_e32 %0, %1, %0" : "+v"(l_reg) : "v"(x_)); else if ((r_ & 3) == 1) asm volatile("v_add_f32_e32 %0, %1, %0" : "+v"(l_b) : "v"(x_)); \
        else if ((r_ & 3) == 2) asm volatile("v_add_f32_e32 %0, %1, %0" : "+v"(l_c) : "v"(x_)); else asm volatile("v_add_f32_e32 %0, %1, %0" : "+v"(l_d) : "v"(x_)); } } while (0)
#define MLA_VTR(i) vf[i] = vtr(vp0 + sl_prev + ((i) >> 1) * 1024 + ((i) & 1) * 512)
#define MLA_VTR2(d, i) vf[d] = vtr(vp0 + sl_prev + ((i) >> 1) * 1024 + ((i) & 1) * 512)
#define MLA_KLD(g, sx) do { kf[2 * (g) + (sx)].lo = *(const LAS i32x4m*)(kp0 + sl_next + (sx) * 4096 + (g) * 512); kf[2 * (g) + (sx)].hi = *(const LAS i32x4m*)(kp0 + sl_next + (sx) * 4096 + (g) * 512 + 1024); } while (0)
#define MLA_PV(O, PA, i) do { const bf16x8 vb_ = PKV(vf[i], vf[(i) + 1]); asm volatile("v_mfma_f32_32x32x16_bf16 %0, %1, %2, %0" : "+v"(O) : "v"(PA), "v"(vb_)); } while (0)
#define MLA_DMA2(t, slot) do { unsigned keep_; asm volatile("s_mov_b32 %0, m0\n\ts_mov_b32 m0, %3\n\ts_nop 0\n\tglobal_load_lds_dwordx4 %1, off\n\ts_mov_b32 m0, %4\n\ts_nop 0\n\tglobal_load_lds_dwordx4 %2, off\n\ts_mov_b32 m0, %0" \
        : "=&s"(keep_) : "v"(ksrc + (size_t)(t) * 6144), "v"(vsrc + (size_t)(t) * 4096), "s"((unsigned)__builtin_amdgcn_readfirstlane(kdst + (slot))), "s"((unsigned)__builtin_amdgcn_readfirstlane(vdst + (slot))) : "memory"); } while (0)
#define MLA_WAITBAR_V() asm volatile("s_waitcnt vmcnt(2)\n\ts_barrier" ::: "memory")
#define MLA_STEP(PC0, PC1, PP0, PP1, j) do { \
        MLA_QK0(PC0, kf[0], qr[0]); MLA_VTR(0); MLA_VTR(1); MLA_VTR(2); MLA_VTR(3); MLA_VTR(4); MLA_VTR(5); MLA_VTR(6); MLA_VTR(7); MLA_EXPN(PP1, 0, 6); \
        MLA_QK0(PC1, kf[2], qr[0]); MLA_EXPN(PP1, 6, 12); MLA_ADDN(PP1, 0, 6); pa0 = PKO(PP0, 0); \
        MLA_QK1(PC0, kf[1], qr[1]); MLA_EXPN(PP1, 12, 16); MLA_ADDN(PP1, 6, 12); pa1 = PKO(PP0, 8); pa2 = PKO(PP1, 0); \
        MLA_QK1(PC1, kf[3], qr[1]); MLA_ADDN(PP1, 12, 16); pa3 = PKO(PP1, 8); \
        asm volatile("" : "+v"(PC0)); \
        MLA_PV(o0, pa0, 0); MLA_VTR2(0, 8); MLA_VTR2(1, 9); MLA_EXPN(PC0, 0, 3); \
        MLA_PV(o0, pa1, 2); MLA_VTR2(2, 10); MLA_VTR2(3, 11); MLA_EXPN(PC0, 3, 6); MLA_ADDN(PC0, 0, 2); \
        MLA_PV(o0, pa2, 4); MLA_VTR2(4, 12); MLA_VTR2(5, 13); MLA_EXPN(PC0, 6, 9); MLA_ADDN(PC0, 2, 5); \
        MLA_PV(o0, pa3, 6); MLA_VTR2(6, 14); MLA_VTR2(7, 15); MLA_EXPN(PC0, 9, 12); MLA_ADDN(PC0, 5, 8); \
        MLA_WAITBAR_V(); if constexpr (RIDER) conv_pre(cv, cv_ld, cv_st, (unsigned)__builtin_amdgcn_readfirstlane(cv_stg)); MLA_DMA2((j) + 3, sl_dma); \
        MLA_PV(o1, pa0, 0); MLA_KLD(0, 0); MLA_EXPN(PC0, 12, 14); MLA_ADDN(PC0, 8, 11); \
        MLA_PV(o1, pa1, 2); MLA_KLD(0, 1); MLA_EXPN(PC0, 14, 16); MLA_ADDN(PC0, 11, 14); \
        MLA_PV(o1, pa2, 4); MLA_KLD(1, 0); MLA_ADDN(PC0, 14, 16); \
        MLA_PV(o1, pa3, 6); MLA_KLD(1, 1); \
        if constexpr (RIDER) conv_post(cv, cv_wr, cv_rd, cv_stgp, cvsetup); \
        MLA_ROT(); } while (0)
#else
#define MLA_STEP(PC0, PC1, PP0, PP1, j) do { \
        if (stag) { MLA_WAITBAR(); MLA_DMA((j) + 3, sl_dma); } \
        SBAR(); mla_qkt(PC0, PC1, kf, qr); mla_vload_h<0>(vf, vp0 + sl_prev); mla_finish(PP0, PP1, l_reg, pa0, pa1, pa2, pa3); SBAR(); \
        if (!stag) { MLA_WAITBAR(); conv_pre(cv, cv_ld, cv_st, (unsigned)__builtin_amdgcn_readfirstlane(cv_stg)); MLA_DMA((j) + 3, sl_dma); } \
        asm volatile("s_nop 15" : "+v"(PC0), "+v"(PC1)); \
        SBAR(); mla_vload_h<1>(vf, vp0 + sl_prev); mla_pv(o0, o1, vf, pa0, pa1, pa2, pa3); mla_kload(kf, kp0 + sl_next); mla_exp(PC0); conv_post(cv, cv_wr, cv_rd, cv_stgp, cvsetup); SBAR(); \
        MLA_ROT(); } while (0)
#endif
#pragma unroll 1
    for (int j = 1; j < 257; j += 2) {
        MLA_STEP(pB0, pB1, pA0, pA1, j);
        MLA_STEP(pA0, pA1, pB0, pB1, j + 1);
    }
    {
#if MLA_ILV
        { float ps = 0.f;
#pragma unroll
          for (int r = 8; r < 16; ++r) ps += pA0[r];
          l_reg = ((l_reg + l_b) + (l_c + l_d)) - ps; }
#endif
#pragma unroll
        for (int r = 8; r < 16; ++r) pA0[r] = 0.f;
#pragma unroll
        for (int r = 0; r < 16; ++r) pA1[r] = 0.f;
#if !MLA_ILV
        float ps = 0.f;
#pragma unroll
        for (int r = 0; r < 8; ++r) ps += pA0[r];
        l_reg += ps;
#endif
        pa0 = PKO(pA0, 0); pa1 = PKO(pA0, 8); pa2 = PKO(pA1, 0); pa3 = PKO(pA1, 8);
        s16x4 vt[16];
        mla_vload(vt, vp0 + sl_prev);
        mla_pv(o0, o1, vt, pa0, pa1, pa2, pa3);
    }
    { auto rr = __builtin_amdgcn_permlane32_swap(__float_as_uint(l_reg), __float_as_uint(l_reg), false, false); l_reg = __uint_as_float(rr[0]) + __uint_as_float(rr[1]); }
    if (hi == 0) li[r32] = l_reg;
    LDS_WAIT(); asm volatile("" ::: "memory");
    unsigned char* yo = (unsigned char*)Y + (size_t)(q0 + wid * 32) * DM + 512 + h * 64 + r32;
#pragma unroll
    for (int r = 0; r < 16; ++r) { const int orow = crow(r, hi); const float rl = __builtin_amdgcn_rcpf(li[orow]) * YSC;
        y8_put(yo + (size_t)orow * DM, o0[r] * rl, o1[r] * rl); }
    asm volatile("s_waitcnt vmcnt(0) lgkmcnt(0)\n\ts_barrier" ::: "memory");
#undef MLA_DMA
#undef MLA_WAITBAR
#undef MLA_ROT
#undef MLA_STEP
}

constexpr int NPHASE = 12;
struct Args { const float* in[N_IN]; float* out; unsigned char* ws; int ph_lo, ph_hi; };
static_assert(sizeof(Args) == N_IN * 8 + 24, "Args has no padding");

__global__ void __launch_bounds__(NWAVES * 64, 2) fwd(Args args) {
    extern __shared__ __attribute__((aligned(16))) unsigned char lds_raw[];
    LAS unsigned char* lds = (LAS unsigned char*)lds_raw;
    volatile LAS unsigned* MISC = (volatile LAS unsigned*)(lds + MISC_OFF);
    const int tid = threadIdx.x, lane = tid & 63, wave = __builtin_amdgcn_readfirstlane(tid >> 6);
    const int G = gridDim.x, bx = blockIdx.x;
    const int gw = bx * NWAVES + wave, NGW = G * NWAVES;
    unsigned char* ws = args.ws;
    for (int u = tid; u < (LDS_BYTES - MISC_OFF) / 4; u += NWAVES * 64) ((LAS unsigned*)(lds + MISC_OFF))[u] = 0u;
    __syncthreads();
    XcdBarrier bar; bar.bar = (unsigned*)(ws + WS_CTL) + CW_BAR; bar.x = 0; bar.st = nullptr;
    const bool one_launch = (args.ph_hi - args.ph_lo) > 1;
    if (one_launch) bar = xcd_barrier_post((unsigned*)(ws + WS_CTL) + CW_BAR, MISC + 8);
    const int lo = args.ph_lo, hi_ph = args.ph_hi;
#ifndef PHMASK
#define PHMASK 0xFFF
#endif
#define IN(k) (((PHMASK >> (k)) & 1) && lo <= (k) && (k) < hi_ph)
#ifndef PROBE_REP
#define PROBE_REP -1
#endif
#define REPS(k) for (int rep_ = 0; rep_ < ((PROBE_REP == (k)) ? 2 : 1); ++rep_)
#define SEAM(k) do { if (IN(k) && IN((k) + 1)) xcd_barrier(bar); } while (0)
    const float* x = args.in[I_X];
#define W_IN_T ((bf16_t*)(ws + WS_WIN))
#define W_OUT_T ((bf16_t*)(ws + WS_WOUT))
#define W_QUP_T ((bf16_t*)(ws + WS_WQUP))
#define W_KVUP_T ((bf16_t*)(ws + WS_WKVUP))
#define W1_T ((bf16_t*)(ws + WS_W1))
#define W2_T ((bf16_t*)(ws + WS_W2))
#define ROPE ((float*)(ws + WS_ROPE))
#define A_N ((bf16_t*)(ws + WS_AN))
#define PROJ ((bf16_t*)(ws + WS_PROJ))
#define QS ((bf16_t*)(ws + WS_QS))
#define KS ((bf16_t*)(ws + WS_KS))
#define VS ((bf16_t*)(ws + WS_VS))
#define QL ((bf16_t*)(ws + WS_QL))
#define KVL ((bf16_t*)(ws + WS_KVL))
#define KR ((float*)(ws + WS_KR))
#define QU ((bf16_t*)(ws + WS_QU))
#define KVU ((bf16_t*)(ws + WS_KVU))
#define QM ((bf16_t*)(ws + WS_QM))
#define KM ((bf16_t*)(ws + WS_KM))
#define VM ((bf16_t*)(ws + WS_VM))
#define Y ((bf16_t*)(ws + WS_Y))
#define XS ((bf16_t*)(ws + WS_XS))
#define ACT ((bf16_t*)(ws + WS_ACT))
#define YS ((bf16_t*)(ws + WS_YS))
#define TOPE ((int*)(ws + WS_TOPE))
#define TOPG ((float*)(ws + WS_TOPG))
#define TRANK ((int*)(ws + WS_TRANK))
#define TSLOT ((int*)(ws + WS_TSLOT))
#define SGATE ((float*)(ws + WS_SGATE))
#define CCNT ((int*)(ws + WS_CCNT))
#define ETOT ((int*)(ws + WS_ETOT))
    float* OUT = args.out; bf16_t* H2B = (bf16_t*)(ws + WS_H2B);
    unsigned char* W1F8 = ws + WS_W1; unsigned char* W2F8 = ws + WS_W2; unsigned char* XS8 = ws + WS_XS; unsigned char* ACT8 = ws + WS_ACT;

    if (IN(0)) REPS(0) {
        LAS float* scr = (LAS float*)(lds + wave * 16640);
        constexpr int NI_MOE = 96 * 256, NI_IN = 8 * 37, NI_OUT = 256, NI_QUP = 4 * 12, NI_KVUP = 2 * 16, NITEMS = NI_MOE + NI_IN + NI_OUT + NI_QUP + NI_KVUP;
        const bool conv_in_mla = (G == 256);
        for (int it = conv_in_mla ? NI_MOE + gw : gw; it < NITEMS; it += NGW) {
            int r = it;
            if (r < NI_MOE) { const int mat = r >> 8, which = mat >> 5, e = mat & 31, rr = r & 255, kb = rr >> 5, nb = rr & 31, n0 = nb * 32;
                if (which < 2) tr_item8(args.in[which == 0 ? I_WG : I_WU] + (size_t)e * DM * DFF, 1024, 1024, kb * 128, n0, W1F8, (size_t)e * 2048 + (n0 >> 7) * 256 + which * 128 + (n0 & 127), scr, lane);
                else tr_item8(args.in[I_WD] + (size_t)e * DFF * DM, 1024, 1024, kb * 128, n0, W2F8, (size_t)e * 1024 + n0, scr, lane);
                continue; }
            r -= NI_MOE;
            if (r < NI_IN) { const int kb = r / 37, nb = r % 37; tr_item8(args.in[I_WIN], 1024, INW, kb * 128, nb * 32, (unsigned char*)W_IN_T, (size_t)nb * 32, scr, lane); continue; }
            r -= NI_IN;
            if (r < NI_OUT) { const int kb = r >> 5, nb = r & 31; tr_item8(args.in[I_WOUT], 1024, 1024, kb * 128, nb * 32, (unsigned char*)W_OUT_T, (size_t)nb * 32, scr, lane); continue; }
            r -= NI_OUT;
            if (r < NI_QUP) { const int kb = r / 12, nb = r % 12; tr_item(args.in[I_WQUP], 256, 768, kb * 64, nb * 64, 64, W_QUP_T, (size_t)nb * 64, scr, lane, args.in[I_QLG]); continue; }
            r -= NI_QUP;
            { const int kb = r >> 4, nb = r & 15; tr_item(args.in[I_WKVUP], 128, 1024, kb * 64, nb * 64, 64, W_KVUP_T, (size_t)nb * 64, scr, lane, args.in[I_KVLG]); }
        }
        {
            f32x4 g[4];
#pragma unroll
            for (int j = 0; j < 4; ++j) g[j] = *(const f32x4*)(args.in[I_ANG] + lane * 4 + 256 * j);
            for (int r0 = gw * 2; r0 < LPAD; r0 += NGW * 2) {
                f32x4 v[2][4];
#pragma unroll
                for (int u = 0; u < 2; ++u) { const int r = r0 + u; if (r < LTOK) { const float* src = r < T ? x + (size_t)r * DM : args.in[I_META] + (size_t)(r - T) * DM;
#pragma unroll
                    for (int j = 0; j < 4; ++j) v[u][j] = *(const f32x4*)(src + lane * 4 + 256 * j); } else {
#pragma unroll
                    for (int j = 0; j < 4; ++j) v[u][j] = (f32x4){0.f, 0.f, 0.f, 0.f}; } }
#pragma unroll
                for (int u = 0; u < 2; ++u) { const int r = r0 + u; unsigned* o = (unsigned*)((unsigned char*)A_N + (size_t)r * DM) + lane; float ss = 0.f;
#pragma unroll
                    for (int j = 0; j < 4; ++j) ss += (v[u][j].x * v[u][j].x + v[u][j].y * v[u][j].y) + (v[u][j].z * v[u][j].z + v[u][j].w * v[u][j].w);
                    const float rs = rstd_of(wave_sum(ss), 1024.f);
#pragma unroll
                    for (int j = 0; j < 4; ++j) { const f32x4 y = v[u][j] * (rs * 16.0f) * g[j]; o[64 * j] = pg8::pk4_fp8(y.x, y.y, y.z, y.w); } }
            }
        }
        for (int idx = bx * (NWAVES * 64) + tid; idx < 32 * 1024; idx += G * NWAVES * 64) {
            const int e = idx >> 10, k = idx & 1023; const float v = args.in[I_RW][k * 32 + e] * args.in[I_FNG][k];
            const unsigned hi = pk2(v, 0.f) & 0xffffu; const unsigned lo = pk2(v - bflo(hi), 0.f) & 0xffffu;
            ((bf16_t*)(ws + WS_RWH))[idx] = (bf16_t)hi; ((bf16_t*)(ws + WS_RWL))[idx] = (bf16_t)lo;
        }
        for (int idx = bx * (NWAVES * 64) + tid; idx < LTOK * 16; idx += G * NWAVES * 64) {
            const int r = idx >> 4, i = idx & 15; const int pos = r < T ? r + NMETA : r - T;
            const float inv = 1.0f / exp2f((float)i * (13.287712379549449f / 16.0f));
            const float ang = (float)pos * inv;
            const double k = rint((double)ang * 0.15915494309189535); const double red = (double)ang - k * 6.283185307179586477;
            float c, s; sincos_red(red, c, s);
            *(f32x2*)(ROPE + (size_t)idx * 2) = (f32x2){c, s};
        }
    }
    SEAM(0);
    if (IN(1)) REPS(1) {
        int k8_ = DM / 2; asm volatile("" : "+s"(k8_));
        pg8::Gemm g{A_N, W_IN_T, LPAD, INWP, k8_}; pg8::StaticOrder S; S.init(LPAD, INWP, G, bx);
        pg8::EpiBf16S E{PROJ, INWP, 1.0f / 4096.0f};
        pg8::gemm_phase<pg8::EpiBf16S, pg8::StaticOrder, true, true, true>(lds, g, S, E);
    }
    SEAM(1);
    if (IN(3)) REPS(3) {
        int kq_ = 256, kkv_ = 128; asm volatile("" : "+s"(kq_), "+s"(kkv_));
        { pg8::Gemm g{PROJ + 768, W_QUP_T, T, 768, kq_, INWP}; pg8::StaticOrder S; S.init(T, 768, G, bx); pg8::EpiBf16 E{QU, 768};
          pg8::gemm_phase<pg8::EpiBf16, pg8::StaticOrder, true, true>(lds, g, S, E); }
        { pg8::Gemm g{PROJ + 1024, W_KVUP_T, LPAD, 1024, kkv_, INWP}; pg8::StaticOrder S; S.init(LPAD, 1024, G, (G == 256) ? ((bx + 64) & 255) : bx); pg8::EpiBf16 E{KVU, 1024};
          pg8::gemm_phase<pg8::EpiBf16, pg8::StaticOrder, true, true>(lds, g, S, E); }
    }
    SEAM(3);
    if (IN(4)) REPS(4) {
        for (int r0 = gw * 4; r0 < LTOK; r0 += NGW * 4) {
            P4In xin[4];
#pragma unroll
            for (int u = 0; u < 4; ++u) xin[u] = p4_load(r0 + u, lane, QU, KVU, PROJ, ROPE);
#pragma unroll
            for (int u = 0; u < 4; ++u) p4_token(r0 + u, lane, xin[u], args.in[I_MQG], args.in[I_MKG], QM, KM, VM);
        }
        for (int idx = bx * (NWAVES * 64) + tid; idx < 8 * (NKP - LTOK) * 14; idx += G * NWAVES * 64) {
            const int c = idx % 14, rr = (idx / 14) % (NKP - LTOK), h = idx / (14 * (NKP - LTOK)); const int key = LTOK + rr;
            if (c < 6) *(u32x4*)((unsigned char*)KM + km_off(h, key, c * 16)) = (u32x4){0u, 0u, 0u, 0u}; else *(u32x4*)(VM + vm_off(h, key, (c - 6) * 8)) = (u32x4){0u, 0u, 0u, 0u};
        }
    }
    SEAM(4);
    if (IN(5)) {
        float gq = fabsf(args.in[I_SQG][lane]), gk = fabsf(args.in[I_SKG][lane]);
        const float bound_swa = 8.0f * wave_max(gq) * wave_max(gk) * LOG2E;
#ifndef NO_SWA
        REPS(50) for (int it = bx; it < 256; it += G) swa_item(it >> 1, it & 1, PROJ, args.in[I_SQG], args.in[I_SKG], Y, args.in[I_SINK], bound_swa, lds, tid);
#endif
#ifndef NO_MLA
        ConvSt cv; cv.ci = 0; cv.ct = 0; cv.item0 = (bx * NWAVES + wave) * CONV_NCI; cv.act = (G == 256); cv.rd = (u32x4){0u, 0u, 0u, 0u}; cv.wsrc = nullptr; cv.wdst = nullptr;
        auto cvsetup = [&]() { conv_setup(cv, args.in[I_WG], args.in[I_WU], args.in[I_WD], W1F8, W2F8); };
        if (cv.act) cvsetup();
        REPS(51) for (int it = bx; it < 512; it += G) {
            if (it == bx) mla_unit<true>(it & 7, (it >> 3) * 256, QM, KM, VM, Y, lds, tid, cv, cvsetup); else mla_unit<false>(it & 7, (it >> 3) * 256, QM, KM, VM, Y, lds, tid, cv, cvsetup); }
        if (G == 256) {
            __syncthreads();
            LAS float* scr = (LAS float*)(lds + wave * 16640);
            for (int ci = cv.ci; ci < CONV_NCI; ++ci) { const int item = cv.item0 + ci, mat = item >> 8, which = mat >> 5, e = mat & 31, rr = item & 255, kb = rr >> 5, nb = rr & 31, n0 = nb * 32;
                if (which < 2) tr_item8(args.in[which == 0 ? I_WG : I_WU] + (size_t)e * DM * DFF, 1024, 1024, kb * 128, n0, W1F8, (size_t)e * 2048 + (n0 >> 7) * 256 + which * 128 + (n0 & 127), scr, lane);
                else tr_item8(args.in[I_WD] + (size_t)e * DFF * DM, 1024, 1024, kb * 128, n0, W2F8, (size_t)e * 1024 + n0, scr, lane); }
        }
#endif
    }
    SEAM(5);

#ifdef SELFCHECK
    {
        xcd_barrier(bar);
        unsigned* flags = (unsigned*)(ws + WS_CTL) + 2048;
        LAS float* sbuf = (LAS float*)lds;
        LAS float* red = (LAS float*)(lds + 16400 * 4);
        if (bx < 128) {
            const int h = bx & 7; const int t = (bx < 8) ? bx * 37 : (bx < 16 ? T - 1 - (bx - 8) * 11 : (int)(((unsigned)bx * 2654435761u) >> 18) & (T - 1));
            const unsigned char* q = (const unsigned char*)QM + ((size_t)h * T + t) * 128;
            float lm = -INFINITY;
            for (int j = tid; j < LTOK; j += 512) { float a = 0.f;
                for (int d = 0; d < 96; ++d) a += __builtin_amdgcn_cvt_f32_fp8((int)q[d], 0) * __builtin_amdgcn_cvt_f32_fp8((int)((const unsigned char*)KM)[km_off(h, j, d)], 0);
                a *= (1.0f / 64.0f);
                sbuf[j] = a; lm = fmaxf(lm, a); }
            lm = wave_max(lm); if (lane == 0) red[wave] = lm; __syncthreads();
            float m = red[0]; for (int w = 1; w < 8; ++w) m = fmaxf(m, red[w]); __syncthreads();
            float l = 0.f;
            for (int j = tid; j < LTOK; j += 512) l += exp2f(sbuf[j] - m);
            l = wave_sum(l);
            if (lane == 0) red[wave * 66 + 64] = l;
#pragma unroll 1
            for (int dg = 0; dg < 8; ++dg) { float o[8];
#pragma unroll
                for (int d = 0; d < 8; ++d) o[d] = 0.f;
                for (int j = tid; j < LTOK; j += 512) { const float pj = exp2f(sbuf[j] - m); const bf16_t* v = VM + vm_off(h, j, dg * 8);
#pragma unroll
                    for (int d = 0; d < 8; ++d) o[d] += pj * bflo(v[d]); }
#pragma unroll
                for (int d = 0; d < 8; ++d) { const float od = wave_sum(o[d]); if (lane == 0) red[wave * 66 + dg * 8 + d] = od; } }
            __syncthreads();
            if (tid == 0) { float lt = 0.f; for (int w = 0; w < 8; ++w) lt += red[w * 66 + 64]; float mx = 0.f, me = 0.f;
                for (int d = 0; d < 64; ++d) { float od = 0.f; for (int w = 0; w < 8; ++w) od += red[w * 66 + d]; od /= lt; const float yk = bflo(Y[(size_t)t * DM + 512 + h * 64 + d]); mx = fmaxf(mx, fabsf(od)); me = fmaxf(me, fabsf(od - yk)); }
                const float rel = me / (mx + 1e-12f); atomicMax(flags + 0, __float_as_uint(rel)); }
        } else {
            const int b2 = bx - 128, hq = b2 & 7, kvh = hq >> 2;
            const int t = (b2 < 8) ? b2 * 19 : (b2 < 16 ? T - 1 - (b2 - 8) * 23 : (b2 < 24 ? 120 + (b2 - 16) * 3 : (int)(((unsigned)b2 * 2654435761u) >> 18) & (T - 1)));
            const bf16_t* q = PROJ + (size_t)t * INWP + hq * 64;
            const float slope2 = exp2f(-(float)(hq + 1)) * LOG2E, sink2 = args.in[I_SINK][hq] * LOG2E;
            float qss = 0.f; for (int d = 0; d < 64; ++d) qss += bflo(q[d]) * bflo(q[d]);
            const float qrs = rstd_of(qss, 64.f) * QSCALE_SWA;
            float sc = -INFINITY; int krow = -1;
            if (tid < 16) krow = T + tid; else if (tid < 16 + 257) { const int key = t - 128 + (tid - 16); if (key >= 0 && key < T) krow = key; }
            if (krow >= 0) { const bf16_t* k = PROJ + (size_t)krow * INWP + 512 + kvh * 64; float kss = 0.f; for (int d = 0; d < 64; ++d) kss += bflo(k[d]) * bflo(k[d]);
                const float krs = rstd_of(kss, 64.f); float a = 0.f;
                for (int d = 0; d < 64; ++d) a += (bflo(q[d]) * qrs * args.in[I_SQG][d]) * (bflo(k[d]) * krs * args.in[I_SKG][d]);
                if (tid >= 16) { const int df = krow - t; a -= slope2 * (float)(df < 0 ? -df : df); } sc = a; }
            float lm = wave_max(sc); if (lane == 0) red[wave] = lm; __syncthreads();
            float m = sink2; for (int w = 0; w < 8; ++w) m = fmaxf(m, red[w]); __syncthreads();
            const float pj = krow >= 0 ? exp2f(sc - m) : 0.f;
            float l = wave_sum(pj); float o[64];
            for (int d = 0; d < 64; ++d) { const float vv = krow >= 0 ? bflo(PROJ[(size_t)krow * INWP + 640 + kvh * 64 + d]) : 0.f; o[d] = wave_sum(pj * vv); }
            if (lane == 0) red[wave * 66 + 64] = l;
#pragma unroll
            for (int d = 0; d < 64; ++d) if (lane == 0) red[wave * 66 + d] = o[d];
            __syncthreads();
            if (tid == 0) { float lt = exp2f(sink2 - m); for (int w = 0; w < 8; ++w) lt += red[w * 66 + 64]; float mx = 0.f, me = 0.f;
                for (int d = 0; d < 64; ++d) { float od = 0.f; for (int w = 0; w < 8; ++w) od += red[w * 66 + d]; od /= lt; const float yk = bflo(Y[(size_t)t * DM + hq * 64 + d]); mx = fmaxf(mx, fabsf(od)); me = fmaxf(me, fabsf(od - yk)); }
                const float rel = me / (mx + 1e-12f); atomicMax(flags + 1, __float_as_uint(rel)); }
        }
        __syncthreads();
        {
            const int h = bx & 7; const int r = (bx < 8) ? T + bx : (bx < 16 ? bx * 5 : (int)(((unsigned)(bx + 77) * 2654435761u) >> 18) & (T - 1));
            LAS float* up = (LAS float*)lds;
            const bf16_t* pr = PROJ + (size_t)r * INWP;
            float qss = 0.f, kss = 0.f;
            for (int k = 0; k < 256; ++k) qss += bflo(pr[768 + k]) * bflo(pr[768 + k]);
            for (int k = 0; k < 128; ++k) kss += bflo(pr[1024 + k]) * bflo(pr[1024 + k]);
            const float rq = rstd_of(qss, 256.f), rkv = rstd_of(kss, 128.f);
            if (tid < 96) { float a = 0.f; for (int k = 0; k < 256; ++k) a += bflo(pr[768 + k]) * rq * args.in[I_QLG][k] * args.in[I_WQUP][(size_t)k * 768 + h * 96 + tid]; up[tid] = a; }
            else if (tid < 224) { const int d = tid - 96; float a = 0.f; for (int k = 0; k < 128; ++k) a += bflo(pr[1024 + k]) * rkv * args.in[I_KVLG][k] * args.in[I_WKVUP][(size_t)k * 1024 + h * 128 + d]; up[tid] = a; }
            __syncthreads();
            if (tid == 0) {
                const int pos = r < T ? r + NMETA : r - T; float me = 0.f, mx = 0.f;
                LAS float* kv = up + 224; LAS float* q = up + 320; float ss = 0.f;
                for (int d = 0; d < 64; ++d) kv[d] = up[96 + d];
                for (int d = 0; d < 32; ++d) kv[64 + d] = bflo(pr[1152 + d]);
                for (int d = 0; d < 96; ++d) ss += kv[d] * kv[d];
                float rs = rstd_of(ss, 96.f);
                for (int d = 0; d < 96; ++d) kv[d] = kv[d] * rs * args.in[I_MKG][d];
                for (int i = 0; i < 16; ++i) { const float ang = (float)pos * (1.0f / powf(10000.0f, (float)i / 16.0f)); const float c = cosf(ang), sn = sinf(ang); const float x1 = kv[64 + i], x2 = kv[80 + i]; kv[64 + i] = x1 * c - x2 * sn; kv[80 + i] = x1 * sn + x2 * c; }
                for (int d = 0; d < 96; ++d) { const float got = 0.25f * __builtin_amdgcn_cvt_f32_fp8((int)((const unsigned char*)KM)[km_off(h, r, d)], 0); mx = fmaxf(mx, fabsf(kv[d])); me = fmaxf(me, fabsf(kv[d] - got)); }
                float rel = me / (mx + 1e-12f);
                me = 0.f; mx = 0.f;
                for (int d = 0; d < 64; ++d) { const float want = up[160 + d], got = bflo(VM[vm_off(h, r, d)]); mx = fmaxf(mx, fabsf(want)); me = fmaxf(me, fabsf(want - got)); }
                rel = fmaxf(rel, me / (mx + 1e-12f));
                if (r < T) { ss = 0.f; me = 0.f; mx = 0.f;
                    for (int d = 0; d < 96; ++d) { q[d] = up[d]; ss += q[d] * q[d]; }
                    rs = rstd_of(ss, 96.f) * QSCALE_MLA;
                    for (int d = 0; d < 96; ++d) q[d] = q[d] * rs * args.in[I_MQG][d];
                    for (int i = 0; i < 16; ++i) { const float ang = (float)pos * (1.0f / powf(10000.0f, (float)i / 16.0f)); const float c = cosf(ang), sn = sinf(ang); const float x1 = q[64 + i], x2 = q[80 + i]; q[64 + i] = x1 * c - x2 * sn; q[80 + i] = x1 * sn + x2 * c; }
                    for (int d = 0; d < 96; ++d) { const float got = 0.0625f * __builtin_amdgcn_cvt_f32_fp8((int)((const unsigned char*)QM)[((size_t)h * T + r) * 128 + d], 0); mx = fmaxf(mx, fabsf(q[d])); me = fmaxf(me, fabsf(q[d] - got)); }
                    rel = fmaxf(rel, me / (mx + 1e-12f)); }
                atomicMax(flags + 3, __float_as_uint(rel));
            }
        }
        {
            const int r = (int)(((unsigned)(bx * 512 + tid) * 2654435761u) >> 12) % LTOK, i = tid & 15; const int pos = r < T ? r + NMETA : r - T;
            const float ang = (float)pos * (1.0f / powf(10000.0f, (float)i / 16.0f));
            const float e = fmaxf(fabsf(cosf(ang) - ROPE[((size_t)r * 16 + i) * 2]), fabsf(sinf(ang) - ROPE[((size_t)r * 16 + i) * 2 + 1]));
            atomicMax(flags + 2, __float_as_uint(e));
        }
        __syncthreads();
    }
#endif
    if (IN(6)) REPS(6) {
        int k8_ = DM / 2; asm volatile("" : "+s"(k8_));
        pg8::Gemm g{Y, W_OUT_T, T, DM, k8_}; pg8::StaticOrder S; S.init(T, DM, G, bx);
        pg8::EpiResBf16S E{x, H2B, DM, 1.0f / (YSC * 256.0f)};
        pg8::gemm_phase<pg8::EpiResBf16S, pg8::StaticOrder, true, true, true>(lds, g, S, E);
    }
    SEAM(6);
    if (IN(7)) REPS(7) {
        LAS float* red = (LAS float*)lds;
        LAS float* ssq = (LAS float*)(lds + 32768);
        LAS int* hist = (LAS int*)(lds + MISC_OFF + 256);
        const int tb = wave >> 2, kq = wave & 3, r32 = lane & 31, hh = lane >> 5;
        for (int c = bx; c < 256; c += G) {
            if (tid < 32) hist[tid] = 0;
            const int t = c * 64 + tb * 32 + r32;
            const bf16_t* hrow = H2B + (size_t)t * DM + kq * 256 + hh * 8;
            const bf16_t* wh = (const bf16_t*)(ws + WS_RWH) + r32 * 1024 + kq * 256 + hh * 8; const bf16_t* wl = (const bf16_t*)(ws + WS_RWL) + r32 * 1024 + kq * 256 + hh * 8;
            f32x16 acc = {}; float ss = 0.f;
#pragma unroll 8
            for (int ks = 0; ks < 16; ++ks) {
                const u32x4 bh = *(const u32x4*)(hrow + ks * 16);
                const bf16x8 ah = *(const bf16x8*)(wh + ks * 16), al = *(const bf16x8*)(wl + ks * 16);
                float xv[8]; unpack8(bh, xv);
#pragma unroll
                for (int i = 0; i < 8; ++i) ss += xv[i] * xv[i];
                acc = __builtin_amdgcn_mfma_f32_32x32x16_bf16(ah, __builtin_bit_cast(bf16x8, bh), acc, 0, 0, 0);
                acc = __builtin_amdgcn_mfma_f32_32x32x16_bf16(al, __builtin_bit_cast(bf16x8, bh), acc, 0, 0, 0);
            }
            ss += __shfl_xor(ss, 32);
            if (kq != 0) {
#pragma unroll
                for (int r = 0; r < 16; ++r) red[((tb * 3 + kq - 1) * 16 + r) * 64 + lane] = acc[r];
            }
            if (hh == 0) ssq[(tb * 4 + kq) * 32 + r32] = ss;
            __syncthreads();
            if (kq == 0) {
#pragma unroll
                for (int q = 0; q < 3; ++q)
#pragma unroll
                    for (int r = 0; r < 16; ++r) acc[r] += red[((tb * 3 + q) * 16 + r) * 64 + lane];
                const float rs = rstd_of((ssq[(tb * 4 + 0) * 32 + r32] + ssq[(tb * 4 + 1) * 32 + r32]) + (ssq[(tb * 4 + 2) * 32 + r32] + ssq[(tb * 4 + 3) * 32 + r32]), 1024.f);
                float v0 = -INFINITY, v1 = -INFINITY, v2 = -INFINITY, v3 = -INFINITY; int i0 = 0, i1 = 0, i2 = 0, i3 = 0;
#define P7_INS(VAL, IDX) do { float x_ = (VAL); int xi_ = (IDX); bool c_; float tf_; int ti_; \
                    c_ = x_ > v0; tf_ = c_ ? v0 : x_; ti_ = c_ ? i0 : xi_; v0 = c_ ? x_ : v0; i0 = c_ ? xi_ : i0; x_ = tf_; xi_ = ti_; \
                    c_ = x_ > v1; tf_ = c_ ? v1 : x_; ti_ = c_ ? i1 : xi_; v1 = c_ ? x_ : v1; i1 = c_ ? xi_ : i1; x_ = tf_; xi_ = ti_; \
                    c_ = x_ > v2; tf_ = c_ ? v2 : x_; ti_ = c_ ? i2 : xi_; v2 = c_ ? x_ : v2; i2 = c_ ? xi_ : i2; x_ = tf_; xi_ = ti_; \
                    c_ = x_ > v3; v3 = c_ ? x_ : v3; i3 = c_ ? xi_ : i3; } while (0)
#pragma unroll
                for (int r = 0; r < 16; ++r) { const int e = crow(r, hh); P7_INS(acc[r] * rs + args.in[I_RB][e], e); }
                {
                    const float w0 = __shfl_xor(v0, 32), w1 = __shfl_xor(v1, 32), w2 = __shfl_xor(v2, 32), w3 = __shfl_xor(v3, 32);
                    const int j0 = __shfl_xor(i0, 32), j1 = __shfl_xor(i1, 32), j2 = __shfl_xor(i2, 32), j3 = __shfl_xor(i3, 32);
                    P7_INS(w0, j0); P7_INS(w1, j1); P7_INS(w2, j2); P7_INS(w3, j3);
                }
#undef P7_INS
                if (hh == 0) {
                    const float e1 = __expf(v1 - v0), e2 = __expf(v2 - v0), e3 = __expf(v3 - v0); const float inv = 1.0f / (1.0f + e1 + e2 + e3);
                    const int k0 = __hip_atomic_fetch_add(hist + i0, 1, __ATOMIC_RELAXED, __HIP_MEMORY_SCOPE_WORKGROUP), k1 = __hip_atomic_fetch_add(hist + i1, 1, __ATOMIC_RELAXED, __HIP_MEMORY_SCOPE_WORKGROUP);
                    const int k2 = __hip_atomic_fetch_add(hist + i2, 1, __ATOMIC_RELAXED, __HIP_MEMORY_SCOPE_WORKGROUP), k3 = __hip_atomic_fetch_add(hist + i3, 1, __ATOMIC_RELAXED, __HIP_MEMORY_SCOPE_WORKGROUP);
                    typedef int i32x4t __attribute__((ext_vector_type(4)));
                    *(i32x4t*)(TOPE + t * 4) = (i32x4t){i0, i1, i2, i3}; *(f32x4*)(TOPG + t * 4) = (f32x4){inv, e1 * inv, e2 * inv, e3 * inv}; *(i32x4t*)(TRANK + t * 4) = (i32x4t){k0, k1, k2, k3};
                }
            }
            __syncthreads();
            if (tid < 32) CCNT[c * 32 + tid] = hist[tid];
            __syncthreads();
        }
    }
    SEAM(7);
    if (IN(8)) REPS(8) {
        LAS int* red = (LAS int*)lds;
        LAS int* base_l = (LAS int*)(lds + 8192); LAS int* pst_l = base_l + 32;
        f32x4 g[4];
#pragma unroll
        for (int j = 0; j < 4; ++j) g[j] = *(const f32x4*)(args.in[I_FNG] + lane * 4 + 256 * j);
        for (int c = bx; c < 256; c += G) {
            { const int e = tid & 31, part = tid >> 5; int slt = 0, sall = 0;
              for (int q = 0; q < 16; ++q) { const int cc = part * 16 + q; const int v = CCNT[cc * 32 + e]; sall += v; if (cc < c) slt += v; }
              red[part * 32 + e] = slt; red[512 + part * 32 + e] = sall; }
            __syncthreads();
            if (tid < 32) { int b = 0, tot = 0; for (int p = 0; p < 16; ++p) { b += red[p * 32 + tid]; tot += red[512 + p * 32 + tid]; } base_l[tid] = b; pst_l[32 + tid] = tot; if (c == 0) ETOT[tid] = tot; }
            __syncthreads();
            if (tid == 0) { int acc = 0; for (int e = 0; e < 32; ++e) { pst_l[e] = acc; acc += ((pst_l[32 + e] + 255) >> 8) << 8; } }
            __syncthreads();
            for (int tt = wave * 2; tt < 64; tt += NWAVES * 2) { const int t = c * 64 + tt;
                int slot = 0;
                if (lane < 8) { const int e = TOPE[t * 4 + lane]; slot = pst_l[e] + base_l[e] + TRANK[t * 4 + lane]; SGATE[slot] = TOPG[t * 4 + lane]; TSLOT[t * 4 + lane] = slot; }
                f32x4 v[2][4];
#pragma unroll
                for (int u = 0; u < 2; ++u)
#pragma unroll
                    for (int j = 0; j < 4; ++j) { const u32x2 w = ((const u32x2*)(H2B + (size_t)(t + u) * DM))[lane + 64 * j]; v[u][j] = (f32x4){bflo(w.x), bfhi(w.x), bflo(w.y), bfhi(w.y)}; }
#pragma unroll
                for (int u = 0; u < 2; ++u) {
                    const int s0 = __shfl(slot, 4 * u + 0), s1 = __shfl(slot, 4 * u + 1), s2 = __shfl(slot, 4 * u + 2), s3 = __shfl(slot, 4 * u + 3);
                    float ss = 0.f;
#pragma unroll
                    for (int j = 0; j < 4; ++j) ss += (v[u][j].x * v[u][j].x + v[u][j].y * v[u][j].y) + (v[u][j].z * v[u][j].z + v[u][j].w * v[u][j].w);
                    const float rs = rstd_of(wave_sum(ss), 1024.f);
#pragma unroll
                    for (int j = 0; j < 4; ++j) { const f32x4 y = v[u][j] * (rs * 8.0f) * g[j]; const unsigned w = pg8::pk4_fp8(y.x, y.y, y.z, y.w);
                        ((unsigned*)(XS8 + (size_t)s0 * DM))[lane + 64 * j] = w; ((unsigned*)(XS8 + (size_t)s1 * DM))[lane + 64 * j] = w;
                        ((unsigned*)(XS8 + (size_t)s2 * DM))[lane + 64 * j] = w; ((unsigned*)(XS8 + (size_t)s3 * DM))[lane + 64 * j] = w; }
                }
            }
            __syncthreads();
        }
    }
    SEAM(8);
    LAS int* tile_e = (LAS int*)(lds + MISC_OFF + 512);
    if (IN(9) || IN(10)) {
        if (tid == 0) { int n = 0; for (int e = 0; e < 32; ++e) { const int nt = (ETOT[e] + 255) >> 8; for (int q = 0; q < nt; ++q) tile_e[n++] = e; } tile_e[MAXTILES] = n; }
        __syncthreads();
    }
    if (IN(9)) REPS(9) {
        const int nMt = tile_e[MAXTILES];
        int k8_ = DM / 2; asm volatile("" : "+s"(k8_));
        pg8::Gemm g{(const bf16_t*)XS8, (const bf16_t*)W1F8, 0, 0, k8_}; pg8::MoeOrder S; S.init(nMt, 8, G, bx, (const PG8_LAS int*)tile_e);
        pg8::EpiSwiglu8 E{ACT8, args.in[I_BG], args.in[I_BU]};
        pg8::gemm_phase<pg8::EpiSwiglu8, pg8::MoeOrder, true, true, true>(lds, g, S, E);
    }
    SEAM(9);
    if (IN(10)) REPS(10) {
        const int nMt = tile_e[MAXTILES];
        int k8_ = DFF / 2; asm volatile("" : "+s"(k8_));
        pg8::Gemm g{(const bf16_t*)ACT8, (const bf16_t*)W2F8, 0, 0, k8_}; pg8::MoeOrder S; S.init(nMt, 4, G, bx, (const PG8_LAS int*)tile_e);
        pg8::EpiDown8 E{(unsigned char*)YS, args.in[I_BD], SGATE, 1.0f / 2048.0f};
        pg8::gemm_phase<pg8::EpiDown8, pg8::MoeOrder, true, true, true>(lds, g, S, E);
    }
    SEAM(10);
    if (IN(11)) {
        const unsigned char* y8 = (const unsigned char*)YS;
        for (int t0 = gw * 2; t0 < T; t0 += NGW * 2) {
            int sl[2][4]; u32x2 hw[2][4]; int yv[2][4][4];
#pragma unroll
            for (int u = 0; u < 2; ++u) { const int t = t0 + u;
#pragma unroll
                for (int k = 0; k < 4; ++k) sl[u][k] = TSLOT[t * 4 + k]; }
#pragma unroll
            for (int u = 0; u < 2; ++u)
#pragma unroll
                for (int j = 0; j < 4; ++j) { hw[u][j] = ((const u32x2*)(H2B + (size_t)(t0 + u) * DM))[lane + 64 * j];
#pragma unroll
                    for (int k = 0; k < 4; ++k) yv[u][j][k] = ((const int*)(y8 + (size_t)sl[u][k] * DM))[lane + 64 * j]; }
#define F8B(w, i) __builtin_amdgcn_cvt_f32_fp8(w, i)
#pragma unroll
            for (int u = 0; u < 2; ++u) { float* hrow = OUT + (size_t)(t0 + u) * DM;
#pragma unroll
                for (int j = 0; j < 4; ++j) { const int a = yv[u][j][0], b = yv[u][j][1], c = yv[u][j][2], d = yv[u][j][3];
                    f32x4 h = (f32x4){bflo(hw[u][j].x), bfhi(hw[u][j].x), bflo(hw[u][j].y), bfhi(hw[u][j].y)};
                    h.x += ((F8B(a, 0) + F8B(b, 0)) + (F8B(c, 0) + F8B(d, 0))) * 0.0625f; h.y += ((F8B(a, 1) + F8B(b, 1)) + (F8B(c, 1) + F8B(d, 1))) * 0.0625f;
                    h.z += ((F8B(a, 2) + F8B(b, 2)) + (F8B(c, 2) + F8B(d, 2))) * 0.0625f; h.w += ((F8B(a, 3) + F8B(b, 3)) + (F8B(c, 3) + F8B(d, 3))) * 0.0625f;
                    *(f32x4*)(hrow + lane * 4 + 256 * j) = h; } }
#undef F8B
        }
    }

#ifdef SELFCHECK
    {
        xcd_barrier(bar);
        const unsigned* flags = (const unsigned*)(ws + WS_CTL) + 2048;
        const float e0 = __uint_as_float(__hip_atomic_load(flags + 0, __ATOMIC_RELAXED, __HIP_MEMORY_SCOPE_AGENT)), e1 = __uint_as_float(__hip_atomic_load(flags + 1, __ATOMIC_RELAXED, __HIP_MEMORY_SCOPE_AGENT)), e2 = __uint_as_float(__hip_atomic_load(flags + 2, __ATOMIC_RELAXED, __HIP_MEMORY_SCOPE_AGENT)), e3 = __uint_as_float(__hip_atomic_load(flags + 3, __ATOMIC_RELAXED, __HIP_MEMORY_SCOPE_AGENT));
        float E = 0.f;
#ifndef SC_TOL
#define SC_TOL 0.03f
#endif
        if (!(e0 <= SC_TOL)) E += 1.f; if (!(e1 <= SC_TOL)) E += 2.f; if (!(e2 <= 2e-3f)) E += 4.f; if (!(e3 <= SC_TOL)) E += 8.f;
#ifdef SC_REPORT
        E = SC_REPORT == 0 ? e0 * 1000.f : SC_REPORT == 1 ? e1 * 1000.f : SC_REPORT == 2 ? e2 * 1000.f : e3 * 1000.f;
#endif
        if (E != 0.f) for (int t = gw; t < T; t += NGW) { float* hrow = OUT + (size_t)t * DM;
#pragma unroll
            for (int j = 0; j < 4; ++j) { f32x4 h = *(const f32x4*)(hrow + lane * 4 + 256 * j); h = h * (1.f + E); *(f32x4*)(hrow + lane * 4 + 256 * j) = h; } }
    }
#endif
#undef IN
#undef SEAM
#undef W_IN_T
#undef W_OUT_T
#undef W_QUP_T
#undef W_KVUP_T
#undef W1_T
#undef W2_T
#undef ROPE
#undef A_N
#undef PROJ
#undef QS
#undef KS
#undef VS
#undef QL
#undef KVL
#undef KR
#undef QU
#undef KVU
#undef QM
#undef KM
#undef VM
#undef Y
#undef XS
#undef ACT
#undef YS
#undef TOPE
#undef TOPG
#undef TRANK
#undef TSLOT
#undef SGATE
#undef CCNT
#undef ETOT
}

extern "C" void kernel_launch(void* const* d_in, const int* in_sizes, int n_in, void* d_out, int out_size, void* d_ws, size_t ws_size, hipStream_t stream) {
    static int grid = 0;
    if (grid == 0) {
        if (n_in != N_IN || in_sizes[0] != T * DM || out_size != T * DM || ws_size < WS_END) { fprintf(stderr, "kernel_launch: unexpected shapes: n_in %d in0 %d out %d ws %zu (need %zu)\n", n_in, n_in > 0 ? in_sizes[0] : -1, out_size, ws_size, (size_t)WS_END); grid = -1; return; }
        int dev = 0, cus = 0, per_cu = 0;
        if (hipGetDevice(&dev) != hipSuccess || hipDeviceGetAttribute(&cus, hipDeviceAttributeMultiprocessorCount, dev) != hipSuccess) { grid = -1; return; }
        if (hipFuncSetAttribute((const void*)fwd, hipFuncAttributeMaxDynamicSharedMemorySize, LDS_BYTES) != hipSuccess) { fprintf(stderr, "kernel_launch: hipFuncSetAttribute failed\n"); grid = -1; return; }
        if (hipOccupancyMaxActiveBlocksPerMultiprocessor(&per_cu, (const void*)fwd, NWAVES * 64, LDS_BYTES) != hipSuccess || per_cu < 1) { fprintf(stderr, "kernel_launch: occupancy query reports %d blocks per CU\n", per_cu); grid = -1; return; }
        (void)hipGetLastError();
        grid = cus;
    }
    if (grid < 0) return;
    (void)hipMemsetAsync((char*)d_ws + WS_CTL, 0, CTL_ZERO_BYTES, stream);
    Args a{};
    for (int i = 0; i < N_IN; ++i) a.in[i] = (const float*)d_in[i];
    a.out = (float*)d_out; a.ws = (unsigned char*)d_ws;
#if MK_ONE_LAUNCH
    a.ph_lo = 0; a.ph_hi = NPHASE;
    hipLaunchKernelGGL(fwd, dim3(grid), dim3(NWAVES * 64), LDS_BYTES, stream, a);
#else
    for (int p = 0; p < NPHASE; ++p) { a.ph_lo = p; a.ph_hi = p + 1; hipLaunchKernelGGL(fwd, dim3(grid), dim3(NWAVES * 64), LDS_BYTES, stream, a); }
#endif
    const hipError_t le = hipPeekAtLastError();
    if (le != hipSuccess) fprintf(stderr, "kernel_launch: launch failed: %s\n", hipGetErrorName(le));
}
```

```cpp
#include <hip/hip_runtime.h>
#include <cstdio>
#include <cstdint>
#include <cmath>
#ifndef MK_ONE_LAUNCH
#define MK_ONE_LAUNCH 1
#endif
namespace pg8 {
#define PG8_LAS __attribute__((address_space(3)))
typedef unsigned short bf16_t;
typedef short bf16x8 __attribute__((ext_vector_type(8)));
typedef float f32x4 __attribute__((ext_vector_type(4)));
typedef unsigned u32x4 __attribute__((ext_vector_type(4)));
constexpr int BM = 256, BK = 64, HALF = 128, HTB = HALF * BK * 2  , STAGE_BYTES = 8 * HTB, NXCD = 8, WGM = 8;

__host__ __device__ __forceinline__ int lds_byte(int r, int c) { const int st = (r >> 4) * 2 + (c >> 5), rr = r & 15, cc = c & 31, ob = rr * 64 + cc * 2; return st * 1024 + (ob ^ (((ob >> 9) & 1) << 5)); }
__host__ __device__ __forceinline__ void stage_rc(int b, int& R, int& C) { const int st = b / 1024, sb = b % 1024, swz = sb ^ (((sb >> 9) & 1) << 5); R = (st >> 1) * 16 + swz / 64; C = (st & 1) * 32 + (swz % 64) / 2; }
__host__ __device__ __forceinline__ int perm32(int rho) { const int n = rho >> 4, i = rho & 15; return 8 * (i >> 2) + 4 * n + (i & 3); }

struct Unit { int pm, pn, e, pl; };
struct Gemm { const bf16_t* A; const bf16_t* Bt; int M, N, K; int lda; };

struct StaticOrder {
    int nM, nN, nwg, G, c;
    __host__ __device__ void init(int M, int N, int G_, int c_) { nM = M / BM; nN = N / BM; nwg = nM * nN; G = G_; c = c_; }
    __host__ __device__ bool next(int i, Unit& u) const {
        const long L = (long)i * G + c; if (L >= nwg) return false;
        int wgid = (int)L; { const int q = nwg / NXCD, r = nwg % NXCD, xcd = wgid % NXCD, off = wgid / NXCD; wgid = (xcd < r ? xcd * (q + 1) : r * (q + 1) + (xcd - r) * q) + off; }
        const int nig = WGM * nN, gid = wgid / nig, fm = gid * WGM, gsz = (nM - fm) < WGM ? (nM - fm) : WGM;
        u.pm = fm + ((wgid % nig) % gsz); u.pn = (wgid % nig) / gsz; return true;
    }
    __device__ __forceinline__ void a_ready(const Unit&) const {}
    __device__ __forceinline__ void done(const Unit&) const {}
};


__device__ __forceinline__ unsigned cvt_pk_bf16(float lo, float hi) { unsigned r; asm volatile("v_cvt_pk_bf16_f32 %0, %1, %2" : "=v"(r) : "v"(lo), "v"(hi)); return r; }

struct EpiBf16 {
    static constexpr bool PERM = true, AFTER_DRAIN = false;
    bf16_t* O; int ldc;
    __device__ __forceinline__ void operator()(const f32x4 (&acc)[2][2][4][2], const Unit& u, int wr, int wc, int fr, int fq) const {
        const int row0 = u.pm * BM + wr * 64 + fr, col0 = u.pn * BM + wc * 32 + 8 * fq;
#pragma unroll
        for (int ai = 0; ai < 2; ++ai)
#pragma unroll
            for (int m = 0; m < 4; ++m) { bf16_t* rowp = O + (size_t)(row0 + ai * HALF + m * 16) * ldc + col0;
#pragma unroll
                for (int bj = 0; bj < 2; ++bj) { const f32x4 v0 = acc[ai][bj][m][0], v1 = acc[ai][bj][m][1];
                    u32x4 w; w.x = cvt_pk_bf16(v0[0], v0[1]); w.y = cvt_pk_bf16(v0[2], v0[3]); w.z = cvt_pk_bf16(v1[0], v1[1]); w.w = cvt_pk_bf16(v1[2], v1[3]);
                    *(u32x4*)(rowp + bj * HALF) = w; } }
    }
};
struct EpiBf16S {
    static constexpr bool PERM = true, AFTER_DRAIN = false;
    bf16_t* O; int ldc; float sc;
    __device__ __forceinline__ void operator()(const f32x4 (&acc)[2][2][4][2], const Unit& u, int wr, int wc, int fr, int fq) const {
        const int row0 = u.pm * BM + wr * 64 + fr, col0 = u.pn * BM + wc * 32 + 8 * fq;
#pragma unroll
        for (int ai = 0; ai < 2; ++ai)
#pragma unroll
            for (int m = 0; m < 4; ++m) { bf16_t* rowp = O + (size_t)(row0 + ai * HALF + m * 16) * ldc + col0;
#pragma unroll
                for (int bj = 0; bj < 2; ++bj) { const f32x4 v0 = acc[ai][bj][m][0] * sc, v1 = acc[ai][bj][m][1] * sc;
                    u32x4 w; w.x = cvt_pk_bf16(v0[0], v0[1]); w.y = cvt_pk_bf16(v0[2], v0[3]); w.z = cvt_pk_bf16(v1[0], v1[1]); w.w = cvt_pk_bf16(v1[2], v1[3]);
                    *(u32x4*)(rowp + bj * HALF) = w; } }
    }
};
struct EpiResF32 {
    static constexpr bool PERM = false, AFTER_DRAIN = false;
    const float* base; float* out; int ldc;
    __device__ __forceinline__ void operator()(const f32x4 (&acc)[2][2][4][2], const Unit& u, int wr, int wc, int fr, int fq) const {
        const int row0 = u.pm * BM + wr * 64 + fr, col0 = u.pn * BM + wc * 32 + 4 * fq;
#pragma unroll
        for (int ai = 0; ai < 2; ++ai)
#pragma unroll
            for (int m = 0; m < 4; ++m) { const size_t off = (size_t)(row0 + ai * HALF + m * 16) * ldc + col0;
#pragma unroll
                for (int bj = 0; bj < 2; ++bj)
#pragma unroll
                    for (int n = 0; n < 2; ++n) { const f32x4 b = *(const f32x4*)(base + off + bj * HALF + n * 16); *(f32x4*)(out + off + bj * HALF + n * 16) = b + acc[ai][bj][m][n]; } }
    }
};
struct EpiResBf16 {
    static constexpr bool PERM = true, AFTER_DRAIN = false;
    const float* base; bf16_t* out; int ldc;
    __device__ __forceinline__ void operator()(const f32x4 (&acc)[2][2][4][2], const Unit& u, int wr, int wc, int fr, int fq) const {
        const int row0 = u.pm * BM + wr * 64 + fr, col0 = u.pn * BM + wc * 32 + 8 * fq;
#pragma unroll
        for (int ai = 0; ai < 2; ++ai)
#pragma unroll
            for (int m = 0; m < 4; ++m) { const size_t off = (size_t)(row0 + ai * HALF + m * 16) * ldc + col0;
#pragma unroll
                for (int bj = 0; bj < 2; ++bj) { const f32x4 v0 = *(const f32x4*)(base + off + bj * HALF) + acc[ai][bj][m][0], v1 = *(const f32x4*)(base + off + bj * HALF + 4) + acc[ai][bj][m][1];
                    u32x4 w; w.x = cvt_pk_bf16(v0[0], v0[1]); w.y = cvt_pk_bf16(v0[2], v0[3]); w.z = cvt_pk_bf16(v1[0], v1[1]); w.w = cvt_pk_bf16(v1[2], v1[3]);
                    *(u32x4*)(out + off + bj * HALF) = w; } }
    }
};
struct EpiResBf16S {
    static constexpr bool PERM = true, AFTER_DRAIN = false;
    const float* base; bf16_t* out; int ldc; float sc;
    __device__ __forceinline__ void operator()(const f32x4 (&acc)[2][2][4][2], const Unit& u, int wr, int wc, int fr, int fq) const {
        const int row0 = u.pm * BM + wr * 64 + fr, col0 = u.pn * BM + wc * 32 + 8 * fq;
#pragma unroll
        for (int ai = 0; ai < 2; ++ai)
#pragma unroll
            for (int m = 0; m < 4; ++m) { const size_t off = (size_t)(row0 + ai * HALF + m * 16) * ldc + col0;
#pragma unroll
                for (int bj = 0; bj < 2; ++bj) { const f32x4 v0 = *(const f32x4*)(base + off + bj * HALF) + acc[ai][bj][m][0] * sc, v1 = *(const f32x4*)(base + off + bj * HALF + 4) + acc[ai][bj][m][1] * sc;
                    u32x4 w; w.x = cvt_pk_bf16(v0[0], v0[1]); w.y = cvt_pk_bf16(v0[2], v0[3]); w.z = cvt_pk_bf16(v1[0], v1[1]); w.w = cvt_pk_bf16(v1[2], v1[3]);
                    *(u32x4*)(out + off + bj * HALF) = w; } }
    }
};
__device__ __forceinline__ float swiglu1(float g, float u) {
    g = fminf(g, 7.0f); u = fminf(fmaxf(u, -7.0f), 7.0f);
    const float s = __builtin_amdgcn_rcpf(1.0f + __builtin_amdgcn_exp2f(-1.702f * 1.4426950408889634f * g));
    return (u + 1.0f) * (g * s);
}
struct EpiSwiglu {
    static constexpr bool PERM = true, AFTER_DRAIN = false;
    bf16_t* O; const float* bg; const float* bu;
    __device__ __forceinline__ void operator()(const f32x4 (&acc)[2][2][4][2], const Unit& u, int wr, int wc, int fr, int fq) const {
        const int row0 = u.pm * BM + wr * 64 + fr, col0 = u.pl * HALF + wc * 32 + 8 * fq;
        f32x4 bgv[2], buv[2];
#pragma unroll
        for (int n = 0; n < 2; ++n) { bgv[n] = *(const f32x4*)(bg + u.e * 1024 + col0 + 4 * n); buv[n] = *(const f32x4*)(bu + u.e * 1024 + col0 + 4 * n); }
#pragma unroll
        for (int ai = 0; ai < 2; ++ai)
#pragma unroll
            for (int m = 0; m < 4; ++m) { bf16_t* rowp = O + (size_t)(row0 + ai * HALF + m * 16) * 1024 + col0;
                float r[8];
#pragma unroll
                for (int n = 0; n < 2; ++n) { const f32x4 g = acc[ai][0][m][n] + bgv[n], up = acc[ai][1][m][n] + buv[n];
#pragma unroll
                    for (int i = 0; i < 4; ++i) r[4 * n + i] = swiglu1(g[i], up[i]); }
                u32x4 w; w.x = cvt_pk_bf16(r[0], r[1]); w.y = cvt_pk_bf16(r[2], r[3]); w.z = cvt_pk_bf16(r[4], r[5]); w.w = cvt_pk_bf16(r[6], r[7]);
                *(u32x4*)rowp = w; }
    }
};
struct EpiDown {
    static constexpr bool PERM = true, AFTER_DRAIN = false;
    bf16_t* O; const float* bd; const float* sg; float ascale;
    __device__ __forceinline__ void operator()(const f32x4 (&acc)[2][2][4][2], const Unit& u, int wr, int wc, int fr, int fq) const {
        const int row0 = u.pm * BM + wr * 64 + fr, col0 = u.pl * BM + wc * 32 + 8 * fq;
        f32x4 bv[2][2];
#pragma unroll
        for (int bj = 0; bj < 2; ++bj)
#pragma unroll
            for (int n = 0; n < 2; ++n) bv[bj][n] = *(const f32x4*)(bd + u.e * 1024 + col0 + bj * HALF + 4 * n);
#pragma unroll
        for (int ai = 0; ai < 2; ++ai)
#pragma unroll
            for (int m = 0; m < 4; ++m) { const int row = row0 + ai * HALF + m * 16; const float gt = sg[row]; bf16_t* rowp = O + (size_t)row * 1024 + col0;
#pragma unroll
                for (int bj = 0; bj < 2; ++bj) { const f32x4 v0 = (acc[ai][bj][m][0] * ascale + bv[bj][0]) * gt, v1 = (acc[ai][bj][m][1] * ascale + bv[bj][1]) * gt;
                    u32x4 w; w.x = cvt_pk_bf16(v0[0], v0[1]); w.y = cvt_pk_bf16(v0[2], v0[3]); w.z = cvt_pk_bf16(v1[0], v1[1]); w.w = cvt_pk_bf16(v1[2], v1[3]);
                    *(u32x4*)(rowp + bj * HALF) = w; } }
    }
};
__device__ __forceinline__ unsigned pk4_fp8(float a, float b, float c, float d) {
    a = __builtin_amdgcn_fmed3f(a, -448.f, 448.f); b = __builtin_amdgcn_fmed3f(b, -448.f, 448.f); c = __builtin_amdgcn_fmed3f(c, -448.f, 448.f); d = __builtin_amdgcn_fmed3f(d, -448.f, 448.f);
    int w = 0; w = __builtin_amdgcn_cvt_pk_fp8_f32(a, b, w, false); w = __builtin_amdgcn_cvt_pk_fp8_f32(c, d, w, true); return (unsigned)w;
}
struct EpiSwiglu8 {
    static constexpr bool PERM = true, AFTER_DRAIN = false;
    unsigned char* O; const float* bg; const float* bu;
    __device__ __forceinline__ void operator()(const f32x4 (&acc)[2][2][4][2], const Unit& u, int wr, int wc, int fr, int fq) const {
        const int row0 = u.pm * BM + wr * 64 + fr, col0 = u.pl * HALF + wc * 32 + 8 * fq;
        f32x4 bgv[2], buv[2];
#pragma unroll
        for (int n = 0; n < 2; ++n) { bgv[n] = *(const f32x4*)(bg + u.e * 1024 + col0 + 4 * n); buv[n] = *(const f32x4*)(bu + u.e * 1024 + col0 + 4 * n) + 1.0f; }
#pragma unroll
        for (int ai = 0; ai < 2; ++ai)
#pragma unroll
            for (int m = 0; m < 4; ++m) { unsigned char* rowp = O + (size_t)(row0 + ai * HALF + m * 16) * 1024 + col0;
                float r[8];
#pragma unroll
                for (int n = 0; n < 2; ++n) { const f32x4 g4 = acc[ai][0][m][n] * (1.0f / 2048.0f) + bgv[n], u4 = acc[ai][1][m][n] * (1.0f / 2048.0f) + buv[n];
#pragma unroll
                    for (int i = 0; i < 4; ++i) { const float g = fminf(g4[i], 7.0f), u1 = __builtin_amdgcn_fmed3f(u4[i], -6.0f, 8.0f);
                        const float e = __builtin_amdgcn_exp2f(g * (-1.702f * 1.4426950408889634f));
                        r[4 * n + i] = (g * __builtin_amdgcn_rcpf(__builtin_fmaf(e, 0.125f, 0.125f))) * u1; } }
                int w0 = 0, w1 = 0;
                w0 = __builtin_amdgcn_cvt_pk_fp8_f32(r[0], r[1], w0, false); w0 = __builtin_amdgcn_cvt_pk_fp8_f32(r[2], r[3], w0, true);
                w1 = __builtin_amdgcn_cvt_pk_fp8_f32(r[4], r[5], w1, false); w1 = __builtin_amdgcn_cvt_pk_fp8_f32(r[6], r[7], w1, true);
                typedef unsigned u32x2v __attribute__((ext_vector_type(2)));
                *(u32x2v*)rowp = (u32x2v){(unsigned)w0, (unsigned)w1}; }
    }
};
struct EpiDown8 {
    static constexpr bool PERM = true, AFTER_DRAIN = false;
    unsigned char* O; const float* bd; const float* sg; float ascale;
    __device__ __forceinline__ void operator()(const f32x4 (&acc)[2][2][4][2], const Unit& u, int wr, int wc, int fr, int fq) const {
        const int row0 = u.pm * BM + wr * 64 + fr, col0 = u.pl * BM + wc * 32 + 8 * fq;
        f32x4 bv[2][2];
#pragma unroll
        for (int bj = 0; bj < 2; ++bj)
#pragma unroll
            for (int n = 0; n < 2; ++n) bv[bj][n] = *(const f32x4*)(bd + u.e * 1024 + col0 + bj * HALF + 4 * n);
#pragma unroll
        for (int ai = 0; ai < 2; ++ai)
#pragma unroll
            for (int m = 0; m < 4; ++m) { const int row = row0 + ai * HALF + m * 16; const float gt = sg[row] * 16.0f; unsigned char* rowp = O + (size_t)row * 1024 + col0;
#pragma unroll
                for (int bj = 0; bj < 2; ++bj) { const f32x4 v0 = (acc[ai][bj][m][0] * ascale + bv[bj][0]) * gt, v1 = (acc[ai][bj][m][1] * ascale + bv[bj][1]) * gt;
                    typedef unsigned u32x2v __attribute__((ext_vector_type(2)));
                    *(u32x2v*)(rowp + bj * HALF) = (u32x2v){pk4_fp8(v0[0], v0[1], v0[2], v0[3]), pk4_fp8(v1[0], v1[1], v1[2], v1[3])}; } }
    }
};
struct MoeOrder {
    int nM, nN, nwg, G, c; const PG8_LAS int* tile_e;
    __device__ void init(int nM_, int nN_, int G_, int c_, const PG8_LAS int* te) { nM = nM_; nN = nN_; nwg = nM * nN; G = G_; c = c_; tile_e = te; }
    __device__ bool next(int i, Unit& u) const {
        const long L = (long)i * G + c; if (L >= nwg) return false;
        int wgid = (int)L; { const int q = nwg / NXCD, r = nwg % NXCD, xcd = wgid % NXCD, off = wgid / NXCD; wgid = (xcd < r ? xcd * (q + 1) : r * (q + 1) + (xcd - r) * q) + off; }
        const int nig = WGM * nN, gid = wgid / nig, fm = gid * WGM, gsz = (nM - fm) < WGM ? (nM - fm) : WGM;
        u.pm = fm + ((wgid % nig) % gsz); u.pl = (wgid % nig) / gsz; u.e = tile_e[u.pm]; u.pn = u.e * nN + u.pl; return true;
    }
    __device__ __forceinline__ void a_ready(const Unit&) const {}
    __device__ __forceinline__ void done(const Unit&) const {}
};
typedef int i32x8 __attribute__((ext_vector_type(8)));
typedef int i32x4v __attribute__((ext_vector_type(4)));
template <class Epi, class Sched, bool ALIGN_EPI = false, bool SP2 = false, bool F8 = false>
__device__ __forceinline__ void gemm_phase(PG8_LAS unsigned char* lds, const Gemm g, const Sched& S, const Epi& E) {
    const int tid = threadIdx.x, wid = __builtin_amdgcn_readfirstlane(tid >> 6), lane = tid & 63, wr = wid >> 2, wc = wid & 3, fr = lane & 15, fq = lane >> 4;
    const int K = g.K, nt = K / BK, LDA = g.lda ? g.lda : g.K;
    unsigned voffA[2], voffB[2];
#pragma unroll
    for (int i = 0; i < 2; ++i) { int R, C; stage_rc(tid * 16 + i * 8192, R, C); const int Rb = Epi::PERM ? ((R & ~31) + perm32(R & 31)) : R;
        voffA[i] = (unsigned)(R * LDA + C) * 2u; voffB[i] = (unsigned)(Rb * K + C) * 2u; }
    const size_t kstep = (size_t)(BK * 2);
    const size_t hstep = (size_t)HALF * K * 2;
    const size_t tstep = 2 * hstep; const size_t hstepA = (size_t)HALF * LDA * 2, tstepA = 2 * hstepA;
    const unsigned ldsw = (unsigned)wid * 1024u;
    const int aoff = lds_byte(wr * 64 + fr, fq * 8), boff = lds_byte(wc * 32 + fr, fq * 8);
#define PG8_SA(b, h) (((b) * 2 + (h)) * HTB)
#define PG8_SB(b, h) ((4 + (b) * 2 + (h)) * HTB)
#define PG8_STAGE(bufoff, gbase, voff) do { _Pragma("unroll") for (int _i = 0; _i < 2; ++_i) \
        __builtin_amdgcn_global_load_lds((const unsigned*)((const char*)(gbase) + (voff)[_i]), (PG8_LAS unsigned*)(lds + (bufoff) + ldsw + _i * 8192), 16, 0, 0); } while (0)
#define PG8_LDA(dst, b, h) do { _Pragma("unroll") for (int m = 0; m < 4; ++m) { if constexpr (F8) { dst##8[m].lo = *(const PG8_LAS i32x4v*)(lds + PG8_SA(b, h) + aoff + m * 2048); dst##8[m].hi = *(const PG8_LAS i32x4v*)(lds + PG8_SA(b, h) + aoff + m * 2048 + 1024); } else { _Pragma("unroll") for (int k = 0; k < 2; ++k) dst[m][k] = *(const PG8_LAS bf16x8*)(lds + PG8_SA(b, h) + aoff + m * 2048 + k * 1024); } } } while (0)
#define PG8_LDB(dst, b, h) do { _Pragma("unroll") for (int n = 0; n < 2; ++n) { if constexpr (F8) { dst##8[n].lo = *(const PG8_LAS i32x4v*)(lds + PG8_SB(b, h) + boff + n * 2048); dst##8[n].hi = *(const PG8_LAS i32x4v*)(lds + PG8_SB(b, h) + boff + n * 2048 + 1024); } else { _Pragma("unroll") for (int k = 0; k < 2; ++k) dst[n][k] = *(const PG8_LAS bf16x8*)(lds + PG8_SB(b, h) + boff + n * 2048 + k * 1024); } } } while (0)
#define PG8_MMA(ai, bj, At, Bt) do { __builtin_amdgcn_s_setprio(1); _Pragma("unroll") for (int m = 0; m < 4; ++m) _Pragma("unroll") for (int n = 0; n < 2; ++n) { if constexpr (F8) asm volatile("v_mfma_scale_f32_16x16x128_f8f6f4 %0, %1, %2, %0, %3, %3 op_sel_hi:[0,0,0]" : "+v"(acc[ai][bj][m][n]) : "v"(Bt##8[n]), "v"(At##8[m]), "v"(0x7f7f7f7f)); else { _Pragma("unroll") for (int k = 0; k < 2; ++k) acc[ai][bj][m][n] = __builtin_amdgcn_mfma_f32_16x16x32_bf16(Bt[n][k], At[m][k], acc[ai][bj][m][n], 0, 0, 0); } } __builtin_amdgcn_s_setprio(0); } while (0)
#define PG8_WAIT_V(n) asm volatile("s_waitcnt vmcnt(" #n ")" ::: "memory")
#define PG8_WAIT_L(n) asm volatile("s_waitcnt lgkmcnt(" #n ")" ::: "memory")
#define PG8_BAR __builtin_amdgcn_s_barrier()
#define PG8_SCHED __builtin_amdgcn_sched_barrier(0)
    Unit cur, nxt; int ui = 0;
    if (!S.next(0, cur)) return;
    f32x4 acc[2][2][4][2];
#pragma unroll
    for (int a = 0; a < 2; ++a)
#pragma unroll
        for (int b = 0; b < 2; ++b)
#pragma unroll
            for (int m = 0; m < 4; ++m)
#pragma unroll
                for (int n = 0; n < 2; ++n) acc[a][b][m][n] = (f32x4){0.f, 0.f, 0.f, 0.f};
    bf16x8 At[4][2], B0[2][2], B1[2][2]; i32x8 At8[4], B08[2], B18[2];
    const char* cA = (const char*)g.A + (size_t)cur.pm * tstepA; const char* cB = (const char*)g.Bt + (size_t)cur.pn * tstep;
    S.a_ready(cur);
    if constexpr (SP2) {
        PG8_STAGE(PG8_SB(0, 0), cB, voffB); PG8_STAGE(PG8_SB(0, 1), cB + hstep, voffB); PG8_STAGE(PG8_SA(0, 0), cA, voffA); PG8_STAGE(PG8_SA(0, 1), cA + hstepA, voffA);
        if (wr == 1) PG8_BAR;
        PG8_WAIT_V(2); PG8_BAR;
        PG8_STAGE(PG8_SB(1, 0), cB + kstep, voffB); PG8_STAGE(PG8_SA(1, 0), cA + kstep, voffA); PG8_STAGE(PG8_SB(1, 1), cB + hstep + kstep, voffB);
        PG8_WAIT_V(6); PG8_BAR;
    } else {
        PG8_STAGE(PG8_SB(0, 0), cB, voffB); PG8_STAGE(PG8_SA(0, 0), cA, voffA); PG8_STAGE(PG8_SB(0, 1), cB + hstep, voffB); PG8_STAGE(PG8_SA(0, 1), cA + hstepA, voffA);
        if (wr == 1) PG8_BAR;
        PG8_WAIT_V(4); PG8_BAR;
        PG8_STAGE(PG8_SB(1, 0), cB + kstep, voffB); PG8_STAGE(PG8_SA(1, 0), cA + kstep, voffA); PG8_STAGE(PG8_SB(1, 1), cB + hstep + kstep, voffB);
        PG8_WAIT_V(6); PG8_BAR;
    }
    for (;;) {
        const bool has_next = S.next(ui + 1, nxt);
        const char* nA = has_next ? (const char*)g.A + (size_t)nxt.pm * tstepA : cA; const char* nB = has_next ? (const char*)g.Bt + (size_t)nxt.pn * tstep : cB;
        for (int t = 0; t < nt; t += 2) {
            const bool last = (t == nt - 2);
            const char* a1 = cA + (size_t)(t + 1) * kstep;
            const char* a2 = last ? nA : cA + (size_t)(t + 2) * kstep; const char* b2 = last ? nB : cB + (size_t)(t + 2) * kstep;
            const char* a3 = a2 + kstep; const char* b3 = b2 + kstep;
            if (last && has_next) S.a_ready(nxt);
            if constexpr (SP2) {
            PG8_LDB(B0, 0, 0); PG8_LDB(B1, 0, 1); PG8_SCHED; PG8_LDA(At, 0, 0); PG8_STAGE(PG8_SA(1, 1), a1 + hstepA, voffA);
            PG8_WAIT_V(8); PG8_WAIT_L(0); PG8_BAR; PG8_MMA(0, 0, At, B0); PG8_MMA(0, 1, At, B1); PG8_BAR; PG8_SCHED;
            PG8_LDA(At, 0, 1); PG8_STAGE(PG8_SB(0, 0), b2, voffB); PG8_STAGE(PG8_SB(0, 1), b2 + hstep, voffB); PG8_STAGE(PG8_SA(0, 0), a2, voffA);
            PG8_WAIT_V(8); PG8_WAIT_L(0); PG8_BAR; PG8_MMA(1, 0, At, B0); PG8_MMA(1, 1, At, B1); PG8_BAR; PG8_SCHED;
            PG8_LDB(B0, 1, 0); PG8_LDB(B1, 1, 1); PG8_SCHED; PG8_LDA(At, 1, 0); PG8_STAGE(PG8_SA(0, 1), a2 + hstepA, voffA);
            PG8_WAIT_V(8); PG8_WAIT_L(0); PG8_BAR; PG8_MMA(0, 0, At, B0); PG8_MMA(0, 1, At, B1); PG8_BAR; PG8_SCHED;
            PG8_LDA(At, 1, 1); PG8_STAGE(PG8_SB(1, 0), b3, voffB); PG8_STAGE(PG8_SB(1, 1), b3 + hstep, voffB); PG8_STAGE(PG8_SA(1, 0), a3, voffA);
            PG8_WAIT_V(8); PG8_WAIT_L(0); PG8_BAR; PG8_MMA(1, 0, At, B0); PG8_MMA(1, 1, At, B1); PG8_BAR; PG8_SCHED;
            } else {
            PG8_LDB(B0, 0, 0); PG8_SCHED; PG8_LDA(At, 0, 0); PG8_STAGE(PG8_SA(1, 1), a1 + hstepA, voffA);
            PG8_WAIT_L(8); PG8_BAR; PG8_WAIT_L(0); PG8_MMA(0, 0, At, B0); PG8_BAR; PG8_SCHED;
            PG8_LDB(B1, 0, 1); PG8_STAGE(PG8_SB(0, 0), b2, voffB);
            PG8_BAR; PG8_WAIT_L(0); PG8_MMA(0, 1, At, B1); PG8_BAR;
            PG8_LDA(At, 0, 1); PG8_STAGE(PG8_SA(0, 0), a2, voffA);
            PG8_BAR; PG8_WAIT_L(0); PG8_MMA(1, 0, At, B0); PG8_BAR; PG8_SCHED;
            PG8_STAGE(PG8_SB(0, 1), b2 + hstep, voffB);
            PG8_WAIT_V(6); PG8_BAR; PG8_MMA(1, 1, At, B1); PG8_BAR;
            PG8_LDB(B0, 1, 0); PG8_SCHED; PG8_LDA(At, 1, 0); PG8_STAGE(PG8_SA(0, 1), a2 + hstepA, voffA);
            PG8_WAIT_L(8); PG8_BAR; PG8_WAIT_L(0); PG8_MMA(0, 0, At, B0); PG8_BAR; PG8_SCHED;
            PG8_LDB(B1, 1, 1); PG8_STAGE(PG8_SB(1, 0), b3, voffB);
            PG8_BAR; PG8_WAIT_L(0); PG8_MMA(0, 1, At, B1); PG8_BAR;
            PG8_LDA(At, 1, 1); PG8_STAGE(PG8_SA(1, 0), a3, voffA);
            PG8_BAR; PG8_WAIT_L(0); PG8_MMA(1, 0, At, B0); PG8_BAR; PG8_SCHED;
            PG8_STAGE(PG8_SB(1, 1), b3 + hstep, voffB);
            PG8_WAIT_V(6); PG8_BAR; PG8_MMA(1, 1, At, B1); PG8_BAR;
            }
        }
        if constexpr (ALIGN_EPI) { if (wr == 0) PG8_BAR; }
        if constexpr (F8) asm volatile("s_nop 15\n\ts_nop 15" ::: "memory");
        if constexpr (!Epi::AFTER_DRAIN) { E(acc, cur, wr, wc, fr, fq); S.done(cur); }
        if (!has_next) break;
#pragma unroll
        for (int a = 0; a < 2; ++a)
#pragma unroll
            for (int b = 0; b < 2; ++b)
#pragma unroll
                for (int m = 0; m < 4; ++m)
#pragma unroll
                    for (int n = 0; n < 2; ++n) acc[a][b][m][n] = (f32x4){0.f, 0.f, 0.f, 0.f};
        cur = nxt; cA = nA; cB = nB; ++ui;
        if constexpr (ALIGN_EPI) { if (wr == 1) PG8_BAR; }
    }
    PG8_WAIT_V(0);
    if constexpr (!ALIGN_EPI) { if (wr == 0) PG8_BAR; }
    PG8_BAR;
    if constexpr (Epi::AFTER_DRAIN) { E.fused(acc, cur, wr, wc, fr, fq, lds, wid, lane); S.done(cur); }
#undef PG8_SA
#undef PG8_SB
#undef PG8_STAGE
#undef PG8_LDA
#undef PG8_LDB
#undef PG8_MMA
#undef PG8_WAIT_V
#undef PG8_WAIT_L
#undef PG8_BAR
#undef PG8_SCHED
}
}

constexpr int T = 16384, NMETA = 16, LTOK = T + NMETA, LPAD = 16640;
constexpr int DM = 1024, INW = 1184, INWP = 1280;
constexpr int NKP = 16640;
constexpr int NEXP = 32, TOPK = 4, DFF = 1024, MAXTILES = 288, MAXSLOTS = MAXTILES * 256;
constexpr float NORM_EPS = 1e-6f, LOG2E = 1.4426950408889634f;
constexpr float QSCALE_SWA = 0.125f * LOG2E;
constexpr float QSCALE_MLA = 0.10206207261596577f * LOG2E;
enum { I_X = 0, I_META, I_ANG, I_WIN, I_SQG, I_SKG, I_SINK, I_QLG, I_WQUP, I_KVLG, I_WKVUP, I_MQG, I_MKG, I_WOUT, I_FNG, I_RW, I_RB, I_WG, I_BG, I_WU, I_BU, I_WD, I_BD, N_IN };

constexpr size_t MiB = 1u << 20;
constexpr size_t WS_CTL = 0, CTL_ZERO_BYTES = 1 * MiB;
constexpr size_t WS_WIN = 1 * MiB;
constexpr size_t WS_WOUT = 4 * MiB;
constexpr size_t WS_WQUP = 6 * MiB;
constexpr size_t WS_WKVUP = 6 * MiB + 512 * 1024;
constexpr size_t WS_ROPE = 7 * MiB;
constexpr size_t WS_TOPE = 9 * MiB + 256 * 1024;
constexpr size_t WS_TOPG = WS_TOPE + 256 * 1024;
constexpr size_t WS_TRANK = WS_TOPG + 256 * 1024;
constexpr size_t WS_TSLOT = WS_TRANK + 256 * 1024;
constexpr size_t WS_SGATE = WS_TSLOT + 256 * 1024;
constexpr size_t WS_CCNT = WS_SGATE + 320 * 1024;
constexpr size_t WS_ETOT = WS_CCNT + 32 * 1024;
constexpr size_t WS_RWH = WS_ETOT + 32 * 1024;
constexpr size_t WS_RWL = WS_RWH + 64 * 1024;
constexpr size_t WS_W1 = 11 * MiB;
constexpr size_t WS_W2 = 139 * MiB;
constexpr size_t WS_AR = 203 * MiB;
constexpr size_t WS_AN = WS_AR;
constexpr size_t WS_PROJ = WS_AR + 33 * MiB;
constexpr size_t WS_QS = WS_AR + 74 * MiB;
constexpr size_t WS_KS = WS_AR + 90 * MiB;
constexpr size_t WS_VS = WS_AR + 95 * MiB;
constexpr size_t WS_QL = WS_AR + 100 * MiB;
constexpr size_t WS_KVL = WS_AR + 108 * MiB;
constexpr size_t WS_KR = WS_AR + 113 * MiB;
constexpr size_t WS_QU = WS_AR + 116 * MiB;
constexpr size_t WS_KVU = WS_AR + 140 * MiB;
constexpr size_t WS_QM = WS_AR + 173 * MiB;
constexpr size_t WS_KM = WS_AR + 197 * MiB;
constexpr size_t WS_VM = WS_AR + 222 * MiB;
constexpr size_t WS_Y = WS_AR + 239 * MiB;
constexpr size_t WS_XS = WS_AR;
constexpr size_t WS_ACT = WS_AR + 144 * MiB;
constexpr size_t WS_YS = WS_XS;
constexpr size_t WS_H2B = WS_AR + 271 * MiB;
constexpr size_t WS_END = WS_AR + 303 * MiB;
static_assert(WS_END <= 512 * MiB, "workspace");
static_assert(WS_RWL + 64 * 1024 <= WS_W1 && WS_ROPE + (size_t)LTOK * 16 * 8 <= WS_TOPE, "small region");
static_assert(WS_Y + (size_t)T * DM * 2 <= WS_END && WS_VM + (size_t)8 * NKP * 64 * 2 <= WS_Y && WS_KM + (size_t)8 * NKP * 96 * 2 <= WS_VM, "arena");
constexpr int CW_BAR = 4096;

constexpr int RING_BYTES = 155648;
constexpr int MISC_OFF = RING_BYTES;
constexpr int LDS_BYTES = 163840;
constexpr int NWAVES = 8;

#define GAS __attribute__((address_space(1)))
#define LAS __attribute__((address_space(3)))
typedef unsigned short bf16_t;
typedef short bf16x8 __attribute__((ext_vector_type(8)));
typedef short s16x4 __attribute__((ext_vector_type(4)));
typedef float f32x4 __attribute__((ext_vector_type(4)));
typedef float f32x2 __attribute__((ext_vector_type(2)));
typedef float f32x16 __attribute__((ext_vector_type(16)));
typedef unsigned u32x4 __attribute__((ext_vector_type(4)));
typedef unsigned u32x2 __attribute__((ext_vector_type(2)));
#define LDS_WAIT() asm volatile("s_waitcnt lgkmcnt(0)" ::: "memory")
#define SBAR() __builtin_amdgcn_sched_barrier(0)
__device__ __forceinline__ unsigned pk2(float lo, float hi) { unsigned r; asm volatile("v_cvt_pk_bf16_f32 %0, %1, %2" : "=v"(r) : "v"(lo), "v"(hi)); return r; }
__device__ __forceinline__ float bflo(unsigned w) { return __uint_as_float(w << 16); }
__device__ __forceinline__ float bfhi(unsigned w) { return __uint_as_float(w & 0xffff0000u); }
__device__ __forceinline__ void unpack8(const u32x4 w, float (&v)[8]) { v[0] = bflo(w.x); v[1] = bfhi(w.x); v[2] = bflo(w.y); v[3] = bfhi(w.y); v[4] = bflo(w.z); v[5] = bfhi(w.z); v[6] = bflo(w.w); v[7] = bfhi(w.w); }
__device__ __forceinline__ float wave_sum(float v) {
#pragma unroll
    for (int o = 1; o < 64; o <<= 1) v += __shfl_xor(v, o);
    return v;
}
__device__ __forceinline__ float wave_max(float v) {
#pragma unroll
    for (int o = 1; o < 64; o <<= 1) v = fmaxf(v, __shfl_xor(v, o));
    return v;
}
__device__ __forceinline__ float rstd_of(float ss, float n) { return 1.0f / sqrtf(ss / n + NORM_EPS); }
__device__ __forceinline__ int crow(int r, int hi) { return (r & 3) + 8 * (r >> 2) + 4 * hi; }

__device__ __forceinline__ void tr_item(const float* __restrict__ W, int K, int N, int k0, int n0, int ncols, bf16_t* WT, size_t drow0, LAS float* scr, int lane, const float* kscale = nullptr) {
    const int lr = lane >> 4, lc = (lane & 15) * 4;
    f32x4 v[16];
    if (lc < ncols) {
#pragma unroll
        for (int i = 0; i < 16; ++i) { v[i] = *(const f32x4*)(W + (size_t)(k0 + i * 4 + lr) * N + n0 + lc); if (kscale) v[i] = v[i] * kscale[k0 + i * 4 + lr]; }
    } else {
#pragma unroll
        for (int i = 0; i < 16; ++i) v[i] = (f32x4){0.f, 0.f, 0.f, 0.f};
    }
#pragma unroll
    for (int i = 0; i < 16; ++i) { LAS float* s = scr + (i * 4 + lr) * 65 + lc; s[0] = v[i].x; s[1] = v[i].y; s[2] = v[i].z; s[3] = v[i].w; }
    LDS_WAIT(); asm volatile("" ::: "memory");
    const int c = lane >> 3, nn = lane & 7;
#pragma unroll
    for (int jj = 0; jj < 8; ++jj) { const int n = nn + 8 * jj; const LAS float* s = scr + (8 * c) * 65 + n;
        u32x4 o; o.x = pk2(s[0], s[65]); o.y = pk2(s[130], s[195]); o.z = pk2(s[260], s[325]); o.w = pk2(s[390], s[455]);
        if (n < ncols) *(u32x4*)(WT + (drow0 + n) * K + k0 + 8 * c) = o; }
    LDS_WAIT(); asm volatile("" ::: "memory");
}
__device__ __forceinline__ unsigned pk4_fp8w(float a, float b, float c, float d) { int w = 0; w = __builtin_amdgcn_cvt_pk_fp8_f32(a * 256.f, b * 256.f, w, false); w = __builtin_amdgcn_cvt_pk_fp8_f32(c * 256.f, d * 256.f, w, true); return (unsigned)w; }
__device__ __forceinline__ void tr_item8(const float* __restrict__ W, int K, int N, int k0, int n0, unsigned char* WT, size_t drow0, LAS float* scr, int lane) {
    const int lr = lane >> 3, lc = (lane & 7) * 4;
    f32x4 v[16];
#pragma unroll
    for (int i = 0; i < 16; ++i) v[i] = __builtin_nontemporal_load((const f32x4*)(W + (size_t)(k0 + i * 8 + lr) * N + n0 + lc));
#pragma unroll
    for (int i = 0; i < 16; ++i) { LAS float* s = scr + lc * 129 + i * 8 + lr; s[0] = v[i].x; s[129] = v[i].y; s[258] = v[i].z; s[387] = v[i].w; }
    LDS_WAIT(); asm volatile("" ::: "memory");
    const int n = lane & 31, c0 = lane >> 5;
#pragma unroll
    for (int jj = 0; jj < 4; ++jj) { const int c = c0 + 2 * jj; const LAS float* s = scr + n * 129 + 16 * c;
        u32x4 o; o.x = pk4_fp8w(s[0], s[1], s[2], s[3]); o.y = pk4_fp8w(s[4], s[5], s[6], s[7]); o.z = pk4_fp8w(s[8], s[9], s[10], s[11]); o.w = pk4_fp8w(s[12], s[13], s[14], s[15]);
        *(u32x4*)(WT + (drow0 + n) * K + k0 + 16 * c) = o; }
    LDS_WAIT(); asm volatile("" ::: "memory");
}
__device__ __forceinline__ void sincos_red(double x, float& c, float& s) {
    const double x2 = x * x;
    double sp = -1.0 / 51090942171709440000.0;
    sp = sp * x2 + 1.0 / 121645100408832000.0;
    sp = sp * x2 - 1.0 / 355687428096000.0;
    sp = sp * x2 + 1.0 / 1307674368000.0;
    sp = sp * x2 - 1.0 / 6227020800.0;
    sp = sp * x2 + 1.0 / 39916800.0;
    sp = sp * x2 - 1.0 / 362880.0;
    sp = sp * x2 + 1.0 / 5040.0;
    sp = sp * x2 - 1.0 / 120.0;
    sp = sp * x2 + 1.0 / 6.0;
    sp = sp * x2 * (-1.0) + 1.0;
    double cp = 1.0 / 1124000727777607680000.0;
    cp = cp * x2 - 1.0 / 2432902008176640000.0;
    cp = cp * x2 + 1.0 / 6402373705728000.0;
    cp = cp * x2 - 1.0 / 20922789888000.0;
    cp = cp * x2 + 1.0 / 87178291200.0;
    cp = cp * x2 - 1.0 / 479001600.0;
    cp = cp * x2 + 1.0 / 3628800.0;
    cp = cp * x2 - 1.0 / 40320.0;
    cp = cp * x2 + 1.0 / 720.0;
    cp = cp * x2 - 1.0 / 24.0;
    cp = cp * x2 + 0.5;
    cp = cp * x2 * (-1.0) + 1.0;
    s = (float)(x * sp); c = (float)cp;
}

#define XB_TMO      128
#define XB_XCNT(j)  (256  + 64 * (j))
#define XB_XSUB(j)  (1280 + 64 * (j))
#define XB_XGEN(j)  (2304 + 64 * (j))
#define XB_TOP      3328
#define XB_TOPGEN   3392
#define XCD_BAR_WORDS 3456
#define XB_SPIN_CAP (1u << 18)

__device__ __forceinline__ unsigned xb_ld(unsigned* p)              { return __hip_atomic_load(p, __ATOMIC_RELAXED, __HIP_MEMORY_SCOPE_AGENT); }
__device__ __forceinline__ unsigned xb_add(unsigned* p, unsigned v) { return __hip_atomic_fetch_add(p, v, __ATOMIC_RELAXED, __HIP_MEMORY_SCOPE_AGENT); }
__device__ __forceinline__ unsigned xb_xcc_id() { return (unsigned)__builtin_amdgcn_s_getreg((3 << 11) | 20) & 0xFu; }
#define XB_SPIN(cond, bar) do { unsigned _sp = 0; while (cond) { __builtin_amdgcn_s_sleep(1); \
    if ((++_sp & 255u) == 0u) { if (xb_ld(&(bar)[XB_TMO])) break; if (_sp > XB_SPIN_CAP) { atomicAdd(&(bar)[XB_TMO], 1u); break; } } } } while (0)

struct XcdBarrier {
    unsigned* bar; unsigned x;
    volatile LAS unsigned* st;
};

__device__ __forceinline__ XcdBarrier xcd_barrier_post(unsigned* bar, volatile LAS unsigned* st) {
    XcdBarrier b; b.bar = bar; b.x = xb_xcc_id(); b.st = st;
    if (threadIdx.x == 0) (void)xb_add(&bar[XB_XCNT(b.x)], 1u);
    return b;
}
__device__ __forceinline__ void xcd_barrier_complete(unsigned* bar, unsigned x, unsigned& nloc, unsigned& nx) {
    const unsigned G = gridDim.x * gridDim.y * gridDim.z;
    unsigned sum, cnt, mine, sp = 0u;
    for (;;) {
        sum = 0u; cnt = 0u; mine = 0u;
#pragma unroll
        for (unsigned j = 0; j < 16; ++j) { const unsigned c = xb_ld(&bar[XB_XCNT(j)]); sum += c; cnt += (c > 0u) ? 1u : 0u; mine = (j == x) ? c : mine; }
        if (sum == G) break;
        __builtin_amdgcn_s_sleep(1);
        if ((++sp & 255u) == 0u) { if (xb_ld(&bar[XB_TMO])) break; if (sp > XB_SPIN_CAP) { atomicAdd(&bar[XB_TMO], 1u); break; } }
    }
    nloc = mine > 0u ? mine : 1u; nx = cnt > 0u ? cnt : 1u;
}

__device__ __forceinline__ void xcd_barrier(const XcdBarrier& b) {
    asm volatile("s_waitcnt vmcnt(0)" ::: "memory");
    __syncthreads();
    if (threadIdx.x == 0) {
        unsigned* bar = b.bar;
        __builtin_amdgcn_s_waitcnt(0);
        unsigned nloc = b.st[0], nx = b.st[1];
        if (nloc == 0u) { xcd_barrier_complete(bar, b.x, nloc, nx); b.st[0] = nloc; b.st[1] = nx; }
        const unsigned old = xb_add(&bar[XB_XSUB(b.x)], 1u);
        const unsigned gen = old / nloc;
        if (old + 1u == (gen + 1u) * nloc) {
            __builtin_amdgcn_fence(__ATOMIC_RELEASE, "agent");
            asm volatile("s_waitcnt vmcnt(0)" ::: "memory");
            const unsigned og = xb_add(&bar[XB_TOP], 1u);
            const unsigned tg = og / nx;
            if (og + 1u == (tg + 1u) * nx) xb_add(&bar[XB_TOPGEN], 1u);
            else XB_SPIN(xb_ld(&bar[XB_TOPGEN]) == tg, bar);
            __builtin_amdgcn_fence(__ATOMIC_ACQUIRE, "agent");
            xb_add(&bar[XB_XGEN(b.x)], 1u);
            asm volatile("s_waitcnt vmcnt(0)" ::: "memory");
        } else {
            XB_SPIN(xb_ld(&bar[XB_XGEN(b.x)]) == gen, bar);
            __builtin_amdgcn_fence(__ATOMIC_ACQUIRE, "agent");
            asm volatile("s_waitcnt vmcnt(0)" ::: "memory");
        }
    }
    __syncthreads();
}

__device__ __forceinline__ size_t km_off(int h, int key, int d) { return ((size_t)h * (NKP / 64) + (key >> 6)) * 6144 + (d >> 4) * 1024 + (key & 63) * 16 + (d & 15); }
__device__ __forceinline__ unsigned pk2_fp8(float a, float b) { return (unsigned)__builtin_amdgcn_cvt_pk_fp8_f32(a, b, 0, false) & 0xffffu; }
__device__ __forceinline__ unsigned pk4_fp8s(float a, float b, float c, float d) { int w = 0; w = __builtin_amdgcn_cvt_pk_fp8_f32(a, b, w, false); w = __builtin_amdgcn_cvt_pk_fp8_f32(c, d, w, true); return (unsigned)w; }
__device__ __forceinline__ size_t vm_off(int h, int key, int c) { return ((size_t)h * (NKP / 64) + (key >> 6)) * 4096 + (c >> 5) * 2048 + ((key >> 4) & 3) * 512 + (key & 15) * 32 + (c & 31); }
struct P4In { f32x4 cs; u32x4 kn, wv, qn; u32x2 ql; unsigned kvl, kr1, kr2, w1, w2; };
__device__ __forceinline__ P4In p4_load(int r, int lane, const bf16_t* QU, const bf16_t* KVU, const bf16_t* PROJ, const float* ROPE) {
    const int h = lane >> 3, j = lane & 7; P4In x;
    x.cs = *(const f32x4*)(ROPE + ((size_t)r * 16 + 2 * j) * 2);
    const bf16_t* kp = KVU + (size_t)r * 1024 + h * 128; const bf16_t* pr = PROJ + (size_t)r * INWP;
    x.kn = *(const u32x4*)(kp + 8 * j); x.wv = *(const u32x4*)(kp + 64 + 8 * j);
    x.kvl = *(const unsigned*)(pr + 1024 + 2 * lane);
    x.kr1 = *(const unsigned*)(pr + 1152 + 2 * j); x.kr2 = *(const unsigned*)(pr + 1168 + 2 * j);
    x.qn = (u32x4){0u, 0u, 0u, 0u}; x.w1 = 0u; x.w2 = 0u; x.ql = (u32x2){0u, 0u};
    if (r < T) { const bf16_t* qp = QU + (size_t)r * 768 + h * 96; x.qn = *(const u32x4*)(qp + 8 * j); x.w1 = *(const unsigned*)(qp + 64 + 2 * j); x.w2 = *(const unsigned*)(qp + 80 + 2 * j);
                 x.ql = *(const u32x2*)(pr + 768 + 4 * lane); }
    return x;
}
__device__ __forceinline__ void p4_token(int r, int lane, const P4In& x, const float* mqg, const float* mkg, bf16_t* QM, bf16_t* KM, bf16_t* VM) {
    const int h = lane >> 3, j = lane & 7;
    const f32x4 cs = x.cs;
    {
        const float a0 = bflo(x.kvl), a1 = bfhi(x.kvl);
        const float rkv = rstd_of(wave_sum(a0 * a0 + a1 * a1), 128.f);
        float kn[8]; unpack8(x.kn, kn);
#pragma unroll
        for (int i = 0; i < 8; ++i) kn[i] *= rkv;
        const float x1x = bflo(x.kr1), x1y = bfhi(x.kr1), x2x = bflo(x.kr2), x2y = bfhi(x.kr2);
        float ss = x1x * x1x + x1y * x1y + x2x * x2x + x2y * x2y;
#pragma unroll
        for (int i = 0; i < 8; ++i) ss += kn[i] * kn[i];
        ss += __shfl_xor(ss, 1); ss += __shfl_xor(ss, 2); ss += __shfl_xor(ss, 4);
        const float rs = rstd_of(ss, 96.f); const float* g = mkg + 8 * j;
        const float rk = rs * 4.0f;
        u32x2 o; o.x = pk4_fp8s(kn[0] * rk * g[0], kn[1] * rk * g[1], kn[2] * rk * g[2], kn[3] * rk * g[3]); o.y = pk4_fp8s(kn[4] * rk * g[4], kn[5] * rk * g[5], kn[6] * rk * g[6], kn[7] * rk * g[7]);
        const float y10 = x1x * rk * mkg[64 + 2 * j], y11 = x1y * rk * mkg[65 + 2 * j], y20 = x2x * rk * mkg[80 + 2 * j], y21 = x2y * rk * mkg[81 + 2 * j];
        unsigned char* K8 = (unsigned char*)KM;
        *(u32x2*)(K8 + km_off(h, r, 8 * j)) = o;
        *(unsigned short*)(K8 + km_off(h, r, 64 + 2 * j)) = (unsigned short)pk2_fp8(y10 * cs.x - y20 * cs.y, y11 * cs.z - y21 * cs.w);
        *(unsigned short*)(K8 + km_off(h, r, 80 + 2 * j)) = (unsigned short)pk2_fp8(y10 * cs.y + y20 * cs.x, y11 * cs.w + y21 * cs.z);
        float vv[8]; unpack8(x.wv, vv);
        u32x4 ov; ov.x = pk2(vv[0] * rkv, vv[1] * rkv); ov.y = pk2(vv[2] * rkv, vv[3] * rkv); ov.z = pk2(vv[4] * rkv, vv[5] * rkv); ov.w = pk2(vv[6] * rkv, vv[7] * rkv);
        *(u32x4*)(VM + vm_off(h, r, 8 * j)) = ov;
    }
    if (r < T) {
        const float b0 = bflo(x.ql.x), b1 = bfhi(x.ql.x), b2 = bflo(x.ql.y), b3 = bfhi(x.ql.y);
        const float rq = rstd_of(wave_sum((b0 * b0 + b1 * b1) + (b2 * b2 + b3 * b3)), 256.f);
        float qn[8]; unpack8(x.qn, qn);
#pragma unroll
        for (int i = 0; i < 8; ++i) qn[i] *= rq;
        const float x10 = bflo(x.w1) * rq, x11 = bfhi(x.w1) * rq, x20 = bflo(x.w2) * rq, x21 = bfhi(x.w2) * rq;
        float ss = x10 * x10 + x11 * x11 + x20 * x20 + x21 * x21;
#pragma unroll
        for (int i = 0; i < 8; ++i) ss += qn[i] * qn[i];
        ss += __shfl_xor(ss, 1); ss += __shfl_xor(ss, 2); ss += __shfl_xor(ss, 4);
        const float rs = rstd_of(ss, 96.f) * (QSCALE_MLA * 16.0f); const float* g = mqg + 8 * j;
        u32x2 o; o.x = pk4_fp8s(qn[0] * rs * g[0], qn[1] * rs * g[1], qn[2] * rs * g[2], qn[3] * rs * g[3]); o.y = pk4_fp8s(qn[4] * rs * g[4], qn[5] * rs * g[5], qn[6] * rs * g[6], qn[7] * rs * g[7]);
        const float y10 = x10 * rs * mqg[64 + 2 * j], y11 = x11 * rs * mqg[65 + 2 * j], y20 = x20 * rs * mqg[80 + 2 * j], y21 = x21 * rs * mqg[81 + 2 * j];
        unsigned char* qo = (unsigned char*)QM + ((size_t)h * T + r) * 128;
        *(u32x2*)(qo + 8 * j) = o;
        *(unsigned short*)(qo + 64 + 2 * j) = (unsigned short)pk2_fp8(y10 * cs.x - y20 * cs.y, y11 * cs.z - y21 * cs.w);
        *(unsigned short*)(qo + 80 + 2 * j) = (unsigned short)pk2_fp8(y10 * cs.y + y20 * cs.x, y11 * cs.w + y21 * cs.z);
        *(unsigned*)(qo + 96 + 4 * j) = 0u;
    }
}

__device__ __forceinline__ int v_st16(int k, int c) { const int kk = (k & ~0xC) | ((k & 4) << 1) | ((k & 8) >> 1); return ((kk >> 3) * 2 + (c >> 5)) * 512 + ((kk & 7) * 32 + (c & 31)) * 2; }
__device__ __forceinline__ int v_rd_base(int lane) { return ((lane & 3) << 3) | (((lane >> 2) & 3) << 6) | (((lane >> 4) & 1) << 5) | (((lane >> 5) & 1) << 8); }
constexpr int v_rd_off(int d0, int ks, int half) { return d0 * 512 + ks * 2048 + half * 1024; }
template <int OFF> __device__ __forceinline__ s16x4 tr_read(int vb) { s16x4 r; asm volatile("ds_read_b64_tr_b16 %0, %1 offset:%2" : "=&v"(r) : "v"(vb), "i"(OFF) : "memory"); return r; }
#define PKV(L, H) (bf16x8){L[0], L[1], L[2], L[3], H[0], H[1], H[2], H[3]}
#define PK4(P, BASE, OUT) do { unsigned a0_ = pk2(P[BASE + 0], P[BASE + 1]), a1_ = pk2(P[BASE + 2], P[BASE + 3]);   \
    unsigned b0_ = pk2(P[BASE + 4], P[BASE + 5]), b1_ = pk2(P[BASE + 6], P[BASE + 7]);                              \
    auto r0_ = __builtin_amdgcn_permlane32_swap(a0_, b0_, false, false); auto r1_ = __builtin_amdgcn_permlane32_swap(a1_, b1_, false, false); \
    u32x4 w_ = {r0_[0], r1_[0], r0_[1], r1_[1]}; OUT = __builtin_bit_cast(bf16x8, w_); } while (0)
template <int D0> __device__ __forceinline__ void pv4(f32x16& od, int vb, bf16x8 pa0, bf16x8 pa1, bf16x8 pa2, bf16x8 pa3) {
    const s16x4 l0 = tr_read<v_rd_off(D0, 0, 0)>(vb), h0 = tr_read<v_rd_off(D0, 0, 1)>(vb), l1 = tr_read<v_rd_off(D0, 1, 0)>(vb), h1 = tr_read<v_rd_off(D0, 1, 1)>(vb);
    const s16x4 l2 = tr_read<v_rd_off(D0, 2, 0)>(vb), h2 = tr_read<v_rd_off(D0, 2, 1)>(vb), l3 = tr_read<v_rd_off(D0, 3, 0)>(vb), h3 = tr_read<v_rd_off(D0, 3, 1)>(vb);
    asm volatile("s_waitcnt lgkmcnt(0)" ::: "memory"); SBAR();
    od = __builtin_amdgcn_mfma_f32_32x32x16_bf16(pa0, PKV(l0, h0), od, 0, 0, 0);
    od = __builtin_amdgcn_mfma_f32_32x32x16_bf16(pa1, PKV(l1, h1), od, 0, 0, 0);
    od = __builtin_amdgcn_mfma_f32_32x32x16_bf16(pa2, PKV(l2, h2), od, 0, 0, 0);
    od = __builtin_amdgcn_mfma_f32_32x32x16_bf16(pa3, PKV(l3, h3), od, 0, 0, 0);
}
template <int D0> __device__ __forceinline__ void pv2(f32x16& od, int vb, bf16x8 pa0, bf16x8 pa1) {
    const s16x4 l0 = tr_read<v_rd_off(D0, 0, 0)>(vb), h0 = tr_read<v_rd_off(D0, 0, 1)>(vb), l1 = tr_read<v_rd_off(D0, 1, 0)>(vb), h1 = tr_read<v_rd_off(D0, 1, 1)>(vb);
    asm volatile("s_waitcnt lgkmcnt(0)" ::: "memory"); SBAR();
    od = __builtin_amdgcn_mfma_f32_32x32x16_bf16(pa0, PKV(l0, h0), od, 0, 0, 0);
    od = __builtin_amdgcn_mfma_f32_32x32x16_bf16(pa1, PKV(l1, h1), od, 0, 0, 0);
}

constexpr float YSC = 32.0f;
__device__ __forceinline__ void y8_put(unsigned char* p, float a, float b) {
    const unsigned w = (unsigned)__builtin_amdgcn_cvt_pk_fp8_f32(__builtin_amdgcn_fmed3f(a, -448.f, 448.f), __builtin_amdgcn_fmed3f(b, -448.f, 448.f), 0, false);
    p[0] = (unsigned char)w; p[32] = (unsigned char)(w >> 8);
}
constexpr int SWA_ROWS = 416, SWA_K_BYTES = SWA_ROWS * 128, SWA_SCR = 2 * SWA_K_BYTES;
__device__ __forceinline__ void swa_item(int qb, int kvh, const bf16_t* PROJ, const float* sqg, const float* skg, bf16_t* Y, const float* sink, float bound2, LAS unsigned char* lds, int tid) {
    const int lane = tid & 63, wid = __builtin_amdgcn_readfirstlane(tid >> 6), r32 = lane & 31, hi = lane >> 5;
    constexpr int NPASS = (SWA_ROWS * 8 + NWAVES * 64 - 1) / (NWAVES * 64);
    u32x4 kdv[NPASS], vdv[NPASS];
#pragma unroll
    for (int it = 0; it < NPASS; ++it) {
        const int ch = tid + it * (NWAVES * 64), kl = ch >> 3, c8 = ch & 7;
        int row = -1;
        if (ch < SWA_ROWS * 8) { if (kl < 16) row = T + kl; else if (kl >= 32) { const int key = 128 * (qb - 1) + (kl - 32); if (key >= 0 && key < T) row = key; } }
        kdv[it] = (u32x4){0u, 0u, 0u, 0u}; vdv[it] = kdv[it];
        if (row >= 0) { kdv[it] = *(const u32x4*)(PROJ + (size_t)row * INWP + 512 + kvh * 64 + c8 * 8); vdv[it] = *(const u32x4*)(PROJ + (size_t)row * INWP + 640 + kvh * 64 + c8 * 8); }
    }
#pragma unroll
    for (int it = 0; it < NPASS; ++it) {
        const int ch = tid + it * (NWAVES * 64), kl = ch >> 3, c8 = ch & 7;
        if (ch < SWA_ROWS * 8) {
            u32x4 kd = kdv[it];
            {
                float v[8]; unpack8(kd, v); float ss = 0.f;
#pragma unroll
                for (int i = 0; i < 8; ++i) ss += v[i] * v[i];
                ss += __shfl_xor(ss, 1); ss += __shfl_xor(ss, 2); ss += __shfl_xor(ss, 4);
                const float rs = rstd_of(ss, 64.f); const float* g = skg + c8 * 8;
                kd.x = pk2(v[0] * rs * g[0], v[1] * rs * g[1]); kd.y = pk2(v[2] * rs * g[2], v[3] * rs * g[3]); kd.z = pk2(v[4] * rs * g[4], v[5] * rs * g[5]); kd.w = pk2(v[6] * rs * g[6], v[7] * rs * g[7]); }
            *(LAS u32x4*)(lds + kl * 128 + ((c8 ^ ((kl >> 1) & 7)) << 4)) = kd;
            *(LAS u32x4*)(lds + SWA_K_BYTES + (kl >> 4) * 2048 + v_st16(kl & 15, c8 * 8)) = vdv[it];
        }
    }
    __syncthreads();
    const int hq = kvh * 4 + (wid >> 1);
    const float slope2 = exp2f(-(float)(hq + 1)) * LOG2E, sinkv = sink[hq] * LOG2E;
    const float Mh = fmaxf(bound2, sinkv);
    LAS float* li = (LAS float*)(lds + SWA_SCR) + wid * 64;
    const int vbase = (int)(uintptr_t)(lds + SWA_K_BYTES) + v_rd_base(lane);
#pragma unroll 1
    for (int sb = 0; sb < 2; ++sb) {
        const int rb = (wid & 1) * 2 + sb, r0 = qb * 128 + rb * 32, row = r0 + r32;
        bf16x8 qr[4];
#pragma unroll
        for (int d0 = 0; d0 < 4; ++d0) qr[d0] = *(const bf16x8*)(PROJ + (size_t)row * INWP + hq * 64 + d0 * 16 + hi * 8);
        {
            float ss = 0.f; float qv[4][8];
#pragma unroll
            for (int d0 = 0; d0 < 4; ++d0) { unpack8(__builtin_bit_cast(u32x4, qr[d0]), qv[d0]);
#pragma unroll
                for (int i = 0; i < 8; ++i) ss += qv[d0][i] * qv[d0][i]; }
            ss += __shfl_xor(ss, 32);
            const float rs = rstd_of(ss, 64.f) * QSCALE_SWA;
#pragma unroll
            for (int d0 = 0; d0 < 4; ++d0) { const float* g = sqg + d0 * 16 + hi * 8;
                const u32x4 w = (u32x4){pk2(qv[d0][0] * rs * g[0], qv[d0][1] * rs * g[1]), pk2(qv[d0][2] * rs * g[2], qv[d0][3] * rs * g[3]), pk2(qv[d0][4] * rs * g[4], qv[d0][5] * rs * g[5]), pk2(qv[d0][6] * rs * g[6], qv[d0][7] * rs * g[7])};
                qr[d0] = __builtin_bit_cast(bf16x8, w); } }
        f32x16 o0 = {}, o1 = {}; float lsum = 0.f;
        const float flo = fmaxf(-128.f, (float)(-row)), fhi = fminf(128.f, (float)(T - 1 - row));
#pragma unroll 2
        for (int tt = 0; tt < 10; ++tt) {
            const int tl = (tt == 0) ? 0 : rb + tt;
            const int kl = tl * 32 + r32;
            f32x16 p;
#pragma unroll
            for (int r = 0; r < 16; ++r) p[r] = -Mh;
            const LAS unsigned char* kp = lds + kl * 128; const int sw = (kl >> 1) & 7;
#pragma unroll
            for (int d0 = 0; d0 < 4; ++d0) { const bf16x8 a = *(const LAS bf16x8*)(kp + (((d0 * 2 + hi) ^ sw) << 4)); p = __builtin_amdgcn_mfma_f32_32x32x16_bf16(a, qr[d0], p, 0, 0, 0); }
            const float fbase = (float)(128 * (qb - 1) + 32 * (tl - 1) - row);
#pragma unroll
            for (int r = 0; r < 16; ++r) {
                const int kk = crow(r, hi);
                if (tt == 0) { p[r] = (kk < 16) ? __builtin_amdgcn_exp2f(p[r]) : 0.f; }
                else { const float fd = fbase + (float)kk;
                    const float sv = __builtin_fmaf(-slope2, __builtin_fabsf(fd), p[r]);
                    p[r] = (fd >= flo && fd <= fhi) ? __builtin_amdgcn_exp2f(sv) : 0.f; }
            }
#pragma unroll
            for (int r = 0; r < 16; ++r) lsum += p[r];
            bf16x8 pa0, pa1; PK4(p, 0, pa0); PK4(p, 8, pa1);
            const int vb = vbase + tl * 4096;
            pv2<0>(o0, vb, pa0, pa1); pv2<1>(o1, vb, pa0, pa1);
        }
        { auto rr = __builtin_amdgcn_permlane32_swap(__float_as_uint(lsum), __float_as_uint(lsum), false, false); lsum = __uint_as_float(rr[0]) + __uint_as_float(rr[1]); }
        lsum += __builtin_amdgcn_exp2f(sinkv - Mh);
        if (hi == 0) li[r32] = lsum;
        LDS_WAIT(); asm volatile("" ::: "memory");
        unsigned char* yo = (unsigned char*)Y + (size_t)r0 * DM + hq * 64 + r32;
#pragma unroll
        for (int r = 0; r < 16; ++r) { const int orow = crow(r, hi); const float rl = __builtin_amdgcn_rcpf(li[orow]) * YSC;
            y8_put(yo + (size_t)orow * DM, o0[r] * rl, o1[r] * rl); }
        LDS_WAIT(); asm volatile("" ::: "memory");
    }
    __syncthreads();
}

constexpr int MLA_SLOT = 8192 + 8192, MLA_NS = 5, MLA_SCR = MLA_NS * MLA_SLOT;
__device__ __forceinline__ void glds16(const void* gsrc, unsigned lds_dst) { unsigned keep;
    asm volatile("s_mov_b32 %0, m0\n\ts_mov_b32 m0, %2\n\ts_nop 0\n\tglobal_load_lds_dwordx4 %1, off\n\ts_mov_b32 m0, %0" : "=&s"(keep) : "v"(gsrc), "s"(lds_dst) : "memory"); }
typedef short v4i16_t __attribute__((ext_vector_type(4)));
__device__ __forceinline__ s16x4 vtr(const LAS unsigned char* p) { return __builtin_bit_cast(s16x4, __builtin_amdgcn_ds_read_tr16_b64_v4i16((LAS v4i16_t*)p)); }
typedef int i32x8m __attribute__((ext_vector_type(8)));
typedef int i32x4m __attribute__((ext_vector_type(4)));
__device__ __forceinline__ void mla_kload(i32x8m (&kf)[4], const LAS unsigned char* kp) {
#pragma unroll
    for (int g = 0; g < 2; ++g)
#pragma unroll
        for (int sx = 0; sx < 2; ++sx) { kf[2 * g + sx].lo = *(const LAS i32x4m*)(kp + sx * 4096 + g * 512); kf[2 * g + sx].hi = *(const LAS i32x4m*)(kp + sx * 4096 + g * 512 + 1024); }
}
template <int H> __device__ __forceinline__ void mla_vload_h(s16x4 (&vf)[16], const LAS unsigned char* vp) {
#pragma unroll
    for (int i = 8 * H; i < 8 * H + 8; ++i) vf[i] = vtr(vp + (i >> 1) * 1024 + (i & 1) * 512);
}
__device__ __forceinline__ void mla_vload(s16x4 (&vf)[16], const LAS unsigned char* vp) {
#pragma unroll
    for (int i = 0; i < 16; ++i) vf[i] = vtr(vp + (i >> 1) * 1024 + (i & 1) * 512);
}
__device__ __forceinline__ void mla_qkt(f32x16& p0, f32x16& p1, const i32x8m (&kf)[4], const i32x8m (&qr)[2]) {
    const unsigned sa = 0x7d7d7d7du, sb = 0x7b7b7b7bu;
    asm volatile("v_mfma_scale_f32_32x32x64_f8f6f4 %0, %1, %2, 0, %3, %4 op_sel_hi:[0,0,0]" : "=&v"(p0) : "v"(kf[0]), "v"(qr[0]), "v"(sa), "v"(sb));
    asm volatile("v_mfma_scale_f32_32x32x64_f8f6f4 %0, %1, %2, 0, %3, %4 op_sel_hi:[0,0,0]" : "=&v"(p1) : "v"(kf[2]), "v"(qr[0]), "v"(sa), "v"(sb));
    asm volatile("v_mfma_scale_f32_32x32x64_f8f6f4 %0, %1, %2, %0, %3, %4 op_sel_hi:[0,0,0]" : "+v"(p0) : "v"(kf[1]), "v"(qr[1]), "v"(sa), "v"(sb));
    asm volatile("v_mfma_scale_f32_32x32x64_f8f6f4 %0, %1, %2, %0, %3, %4 op_sel_hi:[0,0,0]" : "+v"(p1) : "v"(kf[3]), "v"(qr[1]), "v"(sa), "v"(sb));
}
__device__ __forceinline__ void mla_pv(f32x16& o0, f32x16& o1, const s16x4 (&vf)[16], bf16x8 pa0, bf16x8 pa1, bf16x8 pa2, bf16x8 pa3) {
    o0 = __builtin_amdgcn_mfma_f32_32x32x16_bf16(pa0, PKV(vf[0], vf[1]), o0, 0, 0, 0);
    o1 = __builtin_amdgcn_mfma_f32_32x32x16_bf16(pa0, PKV(vf[8], vf[9]), o1, 0, 0, 0);
    o0 = __builtin_amdgcn_mfma_f32_32x32x16_bf16(pa1, PKV(vf[2], vf[3]), o0, 0, 0, 0);
    o1 = __builtin_amdgcn_mfma_f32_32x32x16_bf16(pa1, PKV(vf[10], vf[11]), o1, 0, 0, 0);
    o0 = __builtin_amdgcn_mfma_f32_32x32x16_bf16(pa2, PKV(vf[4], vf[5]), o0, 0, 0, 0);
    o1 = __builtin_amdgcn_mfma_f32_32x32x16_bf16(pa2, PKV(vf[12], vf[13]), o1, 0, 0, 0);
    o0 = __builtin_amdgcn_mfma_f32_32x32x16_bf16(pa3, PKV(vf[6], vf[7]), o0, 0, 0, 0);
    o1 = __builtin_amdgcn_mfma_f32_32x32x16_bf16(pa3, PKV(vf[14], vf[15]), o1, 0, 0, 0);
}
__device__ __forceinline__ void mla_exp(f32x16& p) {
#pragma unroll
    for (int r = 0; r < 16; ++r) p[r] = __builtin_amdgcn_exp2f(p[r]);
}
#define PKO(P, B) __builtin_bit_cast(bf16x8, (u32x4){pk2(P[B], P[B + 1]), pk2(P[B + 2], P[B + 3]), pk2(P[B + 4], P[B + 5]), pk2(P[B + 6], P[B + 7])})
__device__ __forceinline__ void mla_finish(f32x16& p0, f32x16& p1, float& l_reg, bf16x8& pa0, bf16x8& pa1, bf16x8& pa2, bf16x8& pa3) {
    mla_exp(p1);
    float ps = 0.f;
#pragma unroll
    for (int r = 0; r < 16; ++r) ps += p0[r];
#pragma unroll
    for (int r = 0; r < 16; ++r) ps += p1[r];
    l_reg += ps;
    pa0 = PKO(p0, 0); pa1 = PKO(p0, 8); pa2 = PKO(p1, 0); pa3 = PKO(p1, 8);
}
constexpr int CONV_NCI = 12, CONV_PITCH = 132, CONV_TILE = 32 * 144;
static_assert(MLA_SCR + 2048 + NWAVES * CONV_TILE + NWAVES * 4096 <= RING_BYTES, "MLA ring + row-sum scratch + conversion tiles + staging must stay below the LDS control words");
struct ConvSt { int ci, ct; bool act; const float* wsrc; unsigned char* wdst; int item0; u32x4 rd; };
__device__ __forceinline__ void conv_setup(ConvSt& c, const float* wg, const float* wu, const float* wd, unsigned char* W1F8, unsigned char* W2F8) {
    const int item = c.item0 + c.ci, mat = item >> 8, which = mat >> 5, e = mat & 31, rr = item & 255, kb = rr >> 5, nb = rr & 31, n0 = nb * 32, k0 = kb * 128;
    const float* W = (which == 0 ? wg : which == 1 ? wu : wd) + (size_t)e * 1024 * 1024;
    c.wsrc = W + (size_t)k0 * 1024 + n0;
    c.wdst = which < 2 ? W1F8 + ((size_t)e * 2048 + (n0 >> 7) * 256 + which * 128 + (n0 & 127)) * 1024 + k0 : W2F8 + ((size_t)e * 1024 + n0) * 1024 + k0;
}
__device__ __forceinline__ void conv_pre(ConvSt& c, unsigned ld_off, unsigned st_off, unsigned stg_lds) {
    if (c.act) {
        if (c.ct < 8) { const float* b0 = c.wsrc + (size_t)c.ct * 16 * 1024; const float* b1 = b0 + 8 * 1024; const unsigned d0 = stg_lds + (c.ct & 1) * 2048, d1 = d0 + 1024; unsigned keep;
            asm volatile("s_nop 4\n\ts_mov_b32 %0, m0\n\ts_mov_b32 m0, %2\n\ts_nop 0\n\tglobal_load_lds_dwordx4 %1, %3 nt\n\ts_mov_b32 m0, %4\n\ts_nop 0\n\tglobal_load_lds_dwordx4 %1, %5 nt\n\ts_mov_b32 m0, %0"
                         : "=&s"(keep) : "v"(ld_off), "s"(d0), "s"(b0), "s"(d1), "s"(b1) : "memory"); }
        else if (c.ct >= 9) { unsigned char* b = c.wdst + (c.ct - 9) * 32;
            asm volatile("s_nop 4\n\tglobal_store_dwordx4 %0, %1, %2\n\ts_nop 1" :: "v"(st_off), "v"(c.rd), "s"(b) : "memory"); }
    }
}
template <class F> __device__ __forceinline__ void conv_post(ConvSt& c, LAS unsigned char* wr_base, const LAS unsigned char* rd_base, const LAS unsigned char* stg, F&& setup) {
    if (c.act) {
        if (c.ct >= 1 && c.ct <= 8) {
            const LAS unsigned char* sp = stg + ((c.ct - 1) & 1) * 2048;
            const f32x4 x0 = *(const LAS f32x4*)sp, x1 = *(const LAS f32x4*)(sp + 1024);
            const unsigned p0 = pk4_fp8w(x0.x, x0.y, x0.z, x0.w), p1 = pk4_fp8w(x1.x, x1.y, x1.z, x1.w);
            LAS unsigned char* w = wr_base + 16 * (c.ct - 1);
            w[0] = (unsigned char)p0; w[CONV_PITCH] = (unsigned char)(p0 >> 8); w[2 * CONV_PITCH] = (unsigned char)(p0 >> 16); w[3 * CONV_PITCH] = (unsigned char)(p0 >> 24);
            w[8] = (unsigned char)p1; w[CONV_PITCH + 8] = (unsigned char)(p1 >> 8); w[2 * CONV_PITCH + 8] = (unsigned char)(p1 >> 16); w[3 * CONV_PITCH + 8] = (unsigned char)(p1 >> 24); }
        if (c.ct >= 8 && c.ct <= 11) { const LAS unsigned* r4 = (const LAS unsigned*)(rd_base + 32 * (c.ct - 8)); c.rd = (u32x4){r4[0], r4[1], r4[2], r4[3]}; }
        ++c.ct;
        if (c.ct == 13) { c.ct = 0; ++c.ci; c.act = c.ci < CONV_NCI; if (c.act) setup(); }
    }
}
#ifndef MLA_ILV
#define MLA_ILV 1
#endif
template <bool RIDER, class F> __device__ __forceinline__ void mla_unit(int h, int q0, const bf16_t* QM, const bf16_t* KM, const bf16_t* VM, bf16_t* Y, LAS unsigned char* lds, int tid, ConvSt& cv, F&& cvsetup) {
    const int lane = tid & 63, wid = __builtin_amdgcn_readfirstlane(tid >> 6), r32 = lane & 31, hi = lane >> 5;
    const unsigned char* Kh = (const unsigned char*)KM + (size_t)h * (NKP / 64) * 6144; const bf16_t* Vh = VM + (size_t)h * (NKP / 64) * 4096;
    LAS float* li = (LAS float*)(lds + MLA_SCR) + wid * 64;
    const unsigned lds0 = (unsigned)(uintptr_t)lds;
    for (int idx = tid; idx < MLA_NS * 128; idx += NWAVES * 64) *(LAS u32x4*)(lds + (idx >> 7) * MLA_SLOT + 6144 + (idx & 127) * 16) = (u32x4){0u, 0u, 0u, 0u};
    constexpr bool two = true;
    const int kch = wid < 6 ? wid : wid - 6;
    const unsigned char* ksrc = Kh + kch * 1024 + lane * 16;
    const bf16_t* vsrc = Vh + wid * 512 + lane * 8;
    const unsigned kdst = lds0 + kch * 1024, vdst = lds0 + 8192 + wid * 1024;
#define MLA_DMA(t, slot) do { if (two) glds16(ksrc + (size_t)(t) * 6144, (unsigned)__builtin_amdgcn_readfirstlane(kdst + (slot))); \
        glds16(vsrc + (size_t)(t) * 4096, (unsigned)__builtin_amdgcn_readfirstlane(vdst + (slot))); } while (0)
#define MLA_WAITBAR() do { if (two) asm volatile("s_waitcnt vmcnt(2) lgkmcnt(0)\n\ts_barrier" ::: "memory"); else asm volatile("s_waitcnt vmcnt(1) lgkmcnt(0)\n\ts_barrier" ::: "memory"); } while (0)
    const unsigned cv_ld = (unsigned)(((lane >> 3) * 1024 + (lane & 7) * 4) * 4), cv_st = (unsigned)((lane & 31) * 1024 + 16 * (lane >> 5));
    LAS unsigned char* cv_tile = lds + MLA_SCR + 2048 + wid * CONV_TILE;
    LAS unsigned char* cv_wr = cv_tile + (lane & 7) * 4 * CONV_PITCH + (lane >> 3); const LAS unsigned char* cv_rd = cv_tile + (lane & 31) * CONV_PITCH + 16 * (lane >> 5);
    const unsigned cv_stg = lds0 + MLA_SCR + 2048 + NWAVES * CONV_TILE + wid * 4096; const LAS unsigned char* cv_stgp = lds + MLA_SCR + 2048 + NWAVES * CONV_TILE + wid * 4096 + lane * 16;
    MLA_DMA(0, 0); MLA_DMA(1, MLA_SLOT);
    i32x8m qr[2];
    { const unsigned char* Qw = (const unsigned char*)QM + ((size_t)h * T + q0 + wid * 32 + r32) * 128 + hi * 32;
#pragma unroll
      for (int sx = 0; sx < 2; ++sx) { qr[sx].lo = *(const i32x4m*)(Qw + sx * 64); qr[sx].hi = *(const i32x4m*)(Qw + sx * 64 + 16); } }
    const LAS unsigned char* kp0 = lds + hi * 2048 + r32 * 16;
    const LAS unsigned char* vp0 = lds + 8192 + v_rd_base(lane);
    float l_reg = 0.f; f32x16 o0 = {}, o1 = {};
    f32x16 pA0, pA1, pB0, pB1; bf16x8 pa0, pa1, pa2, pa3; i32x8m kf[4];
#if MLA_ILV
    s16x4 vf[8];
#else
    s16x4 vf[16];
#endif
    MLA_WAITBAR();
    MLA_DMA(2, 2 * MLA_SLOT);
    mla_kload(kf, kp0);
    mla_qkt(pA0, pA1, kf, qr); asm volatile("s_nop 15\n\ts_nop 15\n\ts_nop 15\n\ts_nop 15\n\ts_nop 15" : "+v"(pA0), "+v"(pA1)); mla_exp(pA0);
    MLA_WAITBAR();
    MLA_DMA(3, 3 * MLA_SLOT);
    mla_kload(kf, kp0 + MLA_SLOT);
    int sl_prev = 0, sl_next = 2 * MLA_SLOT, sl_dma = 4 * MLA_SLOT;
#define MLA_ROT() do { sl_prev = (sl_prev == 4 * MLA_SLOT) ? 0 : sl_prev + MLA_SLOT; sl_next = (sl_next == 4 * MLA_SLOT) ? 0 : sl_next + MLA_SLOT; sl_dma = (sl_dma == 4 * MLA_SLOT) ? 0 : sl_dma + MLA_SLOT; } while (0)
    constexpr bool stag = false;
#if MLA_ILV
    const unsigned sa_ = 0x7d7d7d7du, sb_ = 0x7b7b7b7bu;
    float l_b = 0.f, l_c = 0.f, l_d = 0.f;
#pragma unroll
    for (int r = 0; r < 16; ++r) l_reg += pA0[r];
#define MLA_QK0(P, KF, QR) asm volatile("v_mfma_scale_f32_32x32x64_f8f6f4 %0, %1, %2, 0, %3, %4 op_sel_hi:[0,0,0]" : "=&v"(P) : "v"(KF), "v"(QR), "v"(sa_), "v"(sb_))
#define MLA_QK1(P, KF, QR) asm volatile("v_mfma_scale_f32_32x32x64_f8f6f4 %0, %1, %2, %0, %3, %4 op_sel_hi:[0,0,0]" : "+v"(P) : "v"(KF), "v"(QR), "v"(sa_), "v"(sb_))
#define MLA_EXPN(P, a, b) do { _Pragma("unroll") for (int r_ = (a); r_ < (b); ++r_) { float x_ = P[r_]; asm volatile("v_exp_f32_e32 %0, %0" : "+v"(x_)); P[r_] = x_; } } while (0)
#define MLA_ADDN(P, a, b) do { _Pragma("unroll") for (int r_ = (a); r_ < (b); ++r_) { const float x_ = P[r_]; \
        if ((r_ & 3) == 0) asm volatile("v_add_f32_e32 %0, %1, %0" : "+v"(l_reg) : "v"(x_)); else if ((r_ & 3) == 1) asm volatile("v_add_f32_e32 %0, %1, %0" : "+v"(l_b) : "v"(x_)); \
        else if ((r_ & 3) == 2) asm volatile("v_add_f32_e32 %0, %1, %0" : "+v"(l_c) : "v"(x_)); else asm volatile("v_add_f32_e32 %0, %1, %0" : "+v"(l_d) : "v"(x_)); } } while (0)
#define MLA_VTR(i) vf[i] = vtr(vp0 + sl_prev + ((i) >> 1) * 1024 + ((i) & 1) * 512)
#define MLA_VTR2(d, i) vf[d] = vtr(vp0 + sl_prev + ((i) >> 1) * 1024 + ((i) & 1) * 512)
#define MLA_KLD(g, sx) do { kf[2 * (g) + (sx)].lo = *(const LAS i32x4m*)(kp0 + sl_next + (sx) * 4096 + (g) * 512); kf[2 * (g) + (sx)].hi = *(const LAS i32x4m*)(kp0 + sl_next + (sx) * 4096 + (g) * 512 + 1024); } while (0)
#define MLA_PV(O, PA, i) do { const bf16x8 vb_ = PKV(vf[i], vf[(i) + 1]); asm volatile("v_mfma_f32_32x32x16_bf16 %0, %1, %2, %0" : "+v"(O) : "v"(PA), "v"(vb_)); } while (0)
#define MLA_DMA2(t, slot) do { unsigned keep_; asm volatile("s_mov_b32 %0, m0\n\ts_mov_b32 m0, %3\n\ts_nop 0\n\tglobal_load_lds_dwordx4 %1, off\n\ts_mov_b32 m0, %4\n\ts_nop 0\n\tglobal_load_lds_dwordx4 %2, off\n\ts_mov_b32 m0, %0" \
        : "=&s"(keep_) : "v"(ksrc + (size_t)(t) * 6144), "v"(vsrc + (size_t)(t) * 4096), "s"((unsigned)__builtin_amdgcn_readfirstlane(kdst + (slot))), "s"((unsigned)__builtin_amdgcn_readfirstlane(vdst + (slot))) : "memory"); } while (0)
#define MLA_WAITBAR_V() asm volatile("s_waitcnt vmcnt(2)\n\ts_barrier" ::: "memory")
#define MLA_STEP(PC0, PC1, PP0, PP1, j) do { \
        MLA_QK0(PC0, kf[0], qr[0]); MLA_VTR(0); MLA_VTR(1); MLA_VTR(2); MLA_VTR(3); MLA_VTR(4); MLA_VTR(5); MLA_VTR(6); MLA_VTR(7); MLA_EXPN(PP1, 0, 6); \
        MLA_QK0(PC1, kf[2], qr[0]); MLA_EXPN(PP1, 6, 12); MLA_ADDN(PP1, 0, 6); pa0 = PKO(PP0, 0); \
        MLA_QK1(PC0, kf[1], qr[1]); MLA_EXPN(PP1, 12, 16); MLA_ADDN(PP1, 6, 12); pa1 = PKO(PP0, 8); pa2 = PKO(PP1, 0); \
        MLA_QK1(PC1, kf[3], qr[1]); MLA_ADDN(PP1, 12, 16); pa3 = PKO(PP1, 8); \
        asm volatile("" : "+v"(PC0)); \
        MLA_PV(o0, pa0, 0); MLA_VTR2(0, 8); MLA_VTR2(1, 9); MLA_EXPN(PC0, 0, 3); \
        MLA_PV(o0, pa1, 2); MLA_VTR2(2, 10); MLA_VTR2(3, 11); MLA_EXPN(PC0, 3, 6); MLA_ADDN(PC0, 0, 2); \
        MLA_PV(o0, pa2, 4); MLA_VTR2(4, 12); MLA_VTR2(5, 13); MLA_EXPN(PC0, 6, 9); MLA_ADDN(PC0, 2, 5); \
        MLA_PV(o0, pa3, 6); MLA_VTR2(6, 14); MLA_VTR2(7, 15); MLA_EXPN(PC0, 9, 12); MLA_ADDN(PC0, 5, 8); \
        MLA_WAITBAR_V(); \
        MLA_PV(o1, pa0, 0); MLA_KLD(0, 0); MLA_EXPN(PC0, 12, 14); MLA_ADDN(PC0, 8, 11); \
        if constexpr (RIDER) conv_pre(cv, cv_ld, cv_st, (unsigned)__builtin_amdgcn_readfirstlane(cv_stg)); MLA_DMA2((j) + 3, sl_dma); \
        MLA_PV(o1, pa1, 2); MLA_KLD(0, 1); MLA_EXPN(PC0, 14, 16); MLA_ADDN(PC0, 11, 14); \
        MLA_PV(o1, pa2, 4); MLA_KLD(1, 0); MLA_ADDN(PC0, 14, 16); \
        MLA_PV(o1, pa3, 6); MLA_KLD(1, 1); \
        if constexpr (RIDER) conv_post(cv, cv_wr, cv_rd, cv_stgp, cvsetup); \
        MLA_ROT(); } while (0)
#else
#define MLA_STEP(PC0, PC1, PP0, PP1, j) do { \
        if (stag) { MLA_WAITBAR(); MLA_DMA((j) + 3, sl_dma); } \
        SBAR(); mla_qkt(PC0, PC1, kf, qr); mla_vload_h<0>(vf, vp0 + sl_prev); mla_finish(PP0, PP1, l_reg, pa0, pa1, pa2, pa3); SBAR(); \
        if (!stag) { MLA_WAITBAR(); conv_pre(cv, cv_ld, cv_st, (unsigned)__builtin_amdgcn_readfirstlane(cv_stg)); MLA_DMA((j) + 3, sl_dma); } \
        asm volatile("s_nop 15" : "+v"(PC0), "+v"(PC1)); \
        SBAR(); mla_vload_h<1>(vf, vp0 + sl_prev); mla_pv(o0, o1, vf, pa0, pa1, pa2, pa3); mla_kload(kf, kp0 + sl_next); mla_exp(PC0); conv_post(cv, cv_wr, cv_rd, cv_stgp, cvsetup); SBAR(); \
        MLA_ROT(); } while (0)
#endif
#pragma unroll 1
    for (int j = 1; j < 257; j += 2) {
        MLA_STEP(pB0, pB1, pA0, pA1, j);
        MLA_STEP(pA0, pA1, pB0, pB1, j + 1);
    }
    {
#if MLA_ILV
        { float ps = 0.f;
#pragma unroll
          for (int r = 8; r < 16; ++r) ps += pA0[r];
          l_reg = ((l_reg + l_b) + (l_c + l_d)) - ps; }
#endif
#pragma unroll
        for (int r = 8; r < 16; ++r) pA0[r] = 0.f;
#pragma unroll
        for (int r = 0; r < 16; ++r) pA1[r] = 0.f;
#if !MLA_ILV
        float ps = 0.f;
#pragma unroll
        for (int r = 0; r < 8; ++r) ps += pA0[r];
        l_reg += ps;
#endif
        pa0 = PKO(pA0, 0); pa1 = PKO(pA0, 8); pa2 = PKO(pA1, 0); pa3 = PKO(pA1, 8);
        s16x4 vt[16];
        mla_vload(vt, vp0 + sl_prev);
        mla_pv(o0, o1, vt, pa0, pa1, pa2, pa3);
    }
    { auto rr = __builtin_amdgcn_permlane32_swap(__float_as_uint(l_reg), __float_as_uint(l_reg), false, false); l_reg = __uint_as_float(rr[0]) + __uint_as_float(rr[1]); }
    if (hi == 0) li[r32] = l_reg;
    LDS_WAIT(); asm volatile("" ::: "memory");
    unsigned char* yo = (unsigned char*)Y + (size_t)(q0 + wid * 32) * DM + 512 + h * 64 + r32;
#pragma unroll
    for (int r = 0; r < 16; ++r) { const int orow = crow(r, hi); const float rl = __builtin_amdgcn_rcpf(li[orow]) * YSC;
        y8_put(yo + (size_t)orow * DM, o0[r] * rl, o1[r] * rl); }
    asm volatile("s_waitcnt vmcnt(0) lgkmcnt(0)\n\ts_barrier" ::: "memory");
#undef MLA_DMA
#undef MLA_WAITBAR
#undef MLA_ROT
#undef MLA_STEP
}

constexpr int NPHASE = 12;
struct Args { const float* in[N_IN]; float* out; unsigned char* ws; int ph_lo, ph_hi; };
static_assert(sizeof(Args) == N_IN * 8 + 24, "Args has no padding");

__global__ void __launch_bounds__(NWAVES * 64, 2) fwd(Args args) {
    extern __shared__ __attribute__((aligned(16))) unsigned char lds_raw[];
    LAS unsigned char* lds = (LAS unsigned char*)lds_raw;
    volatile LAS unsigned* MISC = (volatile LAS unsigned*)(lds + MISC_OFF);
    const int tid = threadIdx.x, lane = tid & 63, wave = __builtin_amdgcn_readfirstlane(tid >> 6);
    const int G = gridDim.x, bx = blockIdx.x;
    const int gw = bx * NWAVES + wave, NGW = G * NWAVES;
    unsigned char* ws = args.ws;
    for (int u = tid; u < (LDS_BYTES - MISC_OFF) / 4; u += NWAVES * 64) ((LAS unsigned*)(lds + MISC_OFF))[u] = 0u;
    __syncthreads();
    XcdBarrier bar; bar.bar = (unsigned*)(ws + WS_CTL) + CW_BAR; bar.x = 0; bar.st = nullptr;
    const bool one_launch = (args.ph_hi - args.ph_lo) > 1;
    if (one_launch) bar = xcd_barrier_post((unsigned*)(ws + WS_CTL) + CW_BAR, MISC + 8);
    const int lo = args.ph_lo, hi_ph = args.ph_hi;
#ifndef PHMASK
#define PHMASK 0xFFF
#endif
#define IN(k) (((PHMASK >> (k)) & 1) && lo <= (k) && (k) < hi_ph)
#ifndef PROBE_REP
#define PROBE_REP -1
#endif
#define REPS(k) for (int rep_ = 0; rep_ < ((PROBE_REP == (k)) ? 2 : 1); ++rep_)
#define SEAM(k) do { if (IN(k) && IN((k) + 1)) xcd_barrier(bar); } while (0)
    const float* x = args.in[I_X];
#define W_IN_T ((bf16_t*)(ws + WS_WIN))
#define W_OUT_T ((bf16_t*)(ws + WS_WOUT))
#define W_QUP_T ((bf16_t*)(ws + WS_WQUP))
#define W_KVUP_T ((bf16_t*)(ws + WS_WKVUP))
#define W1_T ((bf16_t*)(ws + WS_W1))
#define W2_T ((bf16_t*)(ws + WS_W2))
#define ROPE ((float*)(ws + WS_ROPE))
#define A_N ((bf16_t*)(ws + WS_AN))
#define PROJ ((bf16_t*)(ws + WS_PROJ))
#define QS ((bf16_t*)(ws + WS_QS))
#define KS ((bf16_t*)(ws + WS_KS))
#define VS ((bf16_t*)(ws + WS_VS))
#define QL ((bf16_t*)(ws + WS_QL))
#define KVL ((bf16_t*)(ws + WS_KVL))
#define KR ((float*)(ws + WS_KR))
#define QU ((bf16_t*)(ws + WS_QU))
#define KVU ((bf16_t*)(ws + WS_KVU))
#define QM ((bf16_t*)(ws + WS_QM))
#define KM ((bf16_t*)(ws + WS_KM))
#define VM ((bf16_t*)(ws + WS_VM))
#define Y ((bf16_t*)(ws + WS_Y))
#define XS ((bf16_t*)(ws + WS_XS))
#define ACT ((bf16_t*)(ws + WS_ACT))
#define YS ((bf16_t*)(ws + WS_YS))
#define TOPE ((int*)(ws + WS_TOPE))
#define TOPG ((float*)(ws + WS_TOPG))
#define TRANK ((int*)(ws + WS_TRANK))
#define TSLOT ((int*)(ws + WS_TSLOT))
#define SGATE ((float*)(ws + WS_SGATE))
#define CCNT ((int*)(ws + WS_CCNT))
#define ETOT ((int*)(ws + WS_ETOT))
    float* OUT = args.out; bf16_t* H2B = (bf16_t*)(ws + WS_H2B);
    unsigned char* W1F8 = ws + WS_W1; unsigned char* W2F8 = ws + WS_W2; unsigned char* XS8 = ws + WS_XS; unsigned char* ACT8 = ws + WS_ACT;

    if (IN(0)) REPS(0) {
        LAS float* scr = (LAS float*)(lds + wave * 16640);
        constexpr int NI_MOE = 96 * 256, NI_IN = 8 * 37, NI_OUT = 256, NI_QUP = 4 * 12, NI_KVUP = 2 * 16, NITEMS = NI_MOE + NI_IN + NI_OUT + NI_QUP + NI_KVUP;
        const bool conv_in_mla = (G == 256);
        for (int it = conv_in_mla ? NI_MOE + gw : gw; it < NITEMS; it += NGW) {
            int r = it;
            if (r < NI_MOE) { const int mat = r >> 8, which = mat >> 5, e = mat & 31, rr = r & 255, kb = rr >> 5, nb = rr & 31, n0 = nb * 32;
                if (which < 2) tr_item8(args.in[which == 0 ? I_WG : I_WU] + (size_t)e * DM * DFF, 1024, 1024, kb * 128, n0, W1F8, (size_t)e * 2048 + (n0 >> 7) * 256 + which * 128 + (n0 & 127), scr, lane);
                else tr_item8(args.in[I_WD] + (size_t)e * DFF * DM, 1024, 1024, kb * 128, n0, W2F8, (size_t)e * 1024 + n0, scr, lane);
                continue; }
            r -= NI_MOE;
            if (r < NI_IN) { const int kb = r / 37, nb = r % 37; tr_item8(args.in[I_WIN], 1024, INW, kb * 128, nb * 32, (unsigned char*)W_IN_T, (size_t)nb * 32, scr, lane); continue; }
            r -= NI_IN;
            if (r < NI_OUT) { const int kb = r >> 5, nb = r & 31; tr_item8(args.in[I_WOUT], 1024, 1024, kb * 128, nb * 32, (unsigned char*)W_OUT_T, (size_t)nb * 32, scr, lane); continue; }
            r -= NI_OUT;
            if (r < NI_QUP) { const int kb = r / 12, nb = r % 12; tr_item(args.in[I_WQUP], 256, 768, kb * 64, nb * 64, 64, W_QUP_T, (size_t)nb * 64, scr, lane, args.in[I_QLG]); continue; }
            r -= NI_QUP;
            { const int kb = r >> 4, nb = r & 15; tr_item(args.in[I_WKVUP], 128, 1024, kb * 64, nb * 64, 64, W_KVUP_T, (size_t)nb * 64, scr, lane, args.in[I_KVLG]); }
        }
        {
            f32x4 g[4];
#pragma unroll
            for (int j = 0; j < 4; ++j) g[j] = *(const f32x4*)(args.in[I_ANG] + lane * 4 + 256 * j);
            for (int r0 = gw * 2; r0 < LPAD; r0 += NGW * 2) {
                f32x4 v[2][4];
#pragma unroll
                for (int u = 0; u < 2; ++u) { const int r = r0 + u; if (r < LTOK) { const float* src = r < T ? x + (size_t)r * DM : args.in[I_META] + (size_t)(r - T) * DM;
#pragma unroll
                    for (int j = 0; j < 4; ++j) v[u][j] = *(const f32x4*)(src + lane * 4 + 256 * j); } else {
#pragma unroll
                    for (int j = 0; j < 4; ++j) v[u][j] = (f32x4){0.f, 0.f, 0.f, 0.f}; } }
#pragma unroll
                for (int u = 0; u < 2; ++u) { const int r = r0 + u; unsigned* o = (unsigned*)((unsigned char*)A_N + (size_t)r * DM) + lane; float ss = 0.f;
#pragma unroll
                    for (int j = 0; j < 4; ++j) ss += (v[u][j].x * v[u][j].x + v[u][j].y * v[u][j].y) + (v[u][j].z * v[u][j].z + v[u][j].w * v[u][j].w);
                    const float rs = rstd_of(wave_sum(ss), 1024.f);
#pragma unroll
                    for (int j = 0; j < 4; ++j) { const f32x4 y = v[u][j] * (rs * 16.0f) * g[j]; o[64 * j] = pg8::pk4_fp8(y.x, y.y, y.z, y.w); } }
            }
        }
        for (int idx = bx * (NWAVES * 64) + tid; idx < 32 * 1024; idx += G * NWAVES * 64) {
            const int e = idx >> 10, k = idx & 1023; const float v = args.in[I_RW][k * 32 + e] * args.in[I_FNG][k];
            const unsigned hi = pk2(v, 0.f) & 0xffffu; const unsigned lo = pk2(v - bflo(hi), 0.f) & 0xffffu;
            ((bf16_t*)(ws + WS_RWH))[idx] = (bf16_t)hi; ((bf16_t*)(ws + WS_RWL))[idx] = (bf16_t)lo;
        }
        for (int idx = bx * (NWAVES * 64) + tid; idx < LTOK * 16; idx += G * NWAVES * 64) {
            const int r = idx >> 4, i = idx & 15; const int pos = r < T ? r + NMETA : r - T;
            const float inv = 1.0f / exp2f((float)i * (13.287712379549449f / 16.0f));
            const float ang = (float)pos * inv;
            const double k = rint((double)ang * 0.15915494309189535); const double red = (double)ang - k * 6.283185307179586477;
            float c, s; sincos_red(red, c, s);
            *(f32x2*)(ROPE + (size_t)idx * 2) = (f32x2){c, s};
        }
    }
    SEAM(0);
    if (IN(1)) REPS(1) {
        int k8_ = DM / 2; asm volatile("" : "+s"(k8_));
        pg8::Gemm g{A_N, W_IN_T, LPAD, INWP, k8_}; pg8::StaticOrder S; S.init(LPAD, INWP, G, bx);
        pg8::EpiBf16S E{PROJ, INWP, 1.0f / 4096.0f};
        pg8::gemm_phase<pg8::EpiBf16S, pg8::StaticOrder, true, true, true>(lds, g, S, E);
    }
    SEAM(1);
    if (IN(3)) REPS(3) {
        int kq_ = 256, kkv_ = 128; asm volatile("" : "+s"(kq_), "+s"(kkv_));
        { pg8::Gemm g{PROJ + 768, W_QUP_T, T, 768, kq_, INWP}; pg8::StaticOrder S; S.init(T, 768, G, bx); pg8::EpiBf16 E{QU, 768};
          pg8::gemm_phase<pg8::EpiBf16, pg8::StaticOrder, true, true>(lds, g, S, E); }
        { pg8::Gemm g{PROJ + 1024, W_KVUP_T, LPAD, 1024, kkv_, INWP}; pg8::StaticOrder S; S.init(LPAD, 1024, G, (G == 256) ? ((bx + 64) & 255) : bx); pg8::EpiBf16 E{KVU, 1024};
          pg8::gemm_phase<pg8::EpiBf16, pg8::StaticOrder, true, true>(lds, g, S, E); }
    }
    SEAM(3);
    if (IN(4)) REPS(4) {
        for (int r0 = gw * 4; r0 < LTOK; r0 += NGW * 4) {
            P4In xin[4];
#pragma unroll
            for (int u = 0; u < 4; ++u) xin[u] = p4_load(r0 + u, lane, QU, KVU, PROJ, ROPE);
#pragma unroll
            for (int u = 0; u < 4; ++u) p4_token(r0 + u, lane, xin[u], args.in[I_MQG], args.in[I_MKG], QM, KM, VM);
        }
        for (int idx = bx * (NWAVES * 64) + tid; idx < 8 * (NKP - LTOK) * 14; idx += G * NWAVES * 64) {
            const int c = idx % 14, rr = (idx / 14) % (NKP - LTOK), h = idx / (14 * (NKP - LTOK)); const int key = LTOK + rr;
            if (c < 6) *(u32x4*)((unsigned char*)KM + km_off(h, key, c * 16)) = (u32x4){0u, 0u, 0u, 0u}; else *(u32x4*)(VM + vm_off(h, key, (c - 6) * 8)) = (u32x4){0u, 0u, 0u, 0u};
        }
    }
    SEAM(4);
    if (IN(5)) {
        float gq = fabsf(args.in[I_SQG][lane]), gk = fabsf(args.in[I_SKG][lane]);
        const float bound_swa = 8.0f * wave_max(gq) * wave_max(gk) * LOG2E;
#ifndef NO_SWA
        REPS(50) for (int it = bx; it < 256; it += G) swa_item(it >> 1, it & 1, PROJ, args.in[I_SQG], args.in[I_SKG], Y, args.in[I_SINK], bound_swa, lds, tid);
#endif
#ifndef NO_MLA
        ConvSt cv; cv.ci = 0; cv.ct = 0; cv.item0 = (bx * NWAVES + wave) * CONV_NCI; cv.act = (G == 256); cv.rd = (u32x4){0u, 0u, 0u, 0u}; cv.wsrc = nullptr; cv.wdst = nullptr;
        auto cvsetup = [&]() { conv_setup(cv, args.in[I_WG], args.in[I_WU], args.in[I_WD], W1F8, W2F8); };
        if (cv.act) cvsetup();
        REPS(51) for (int it = bx; it < 512; it += G) {
            if (it == bx) mla_unit<true>(it & 7, (it >> 3) * 256, QM, KM, VM, Y, lds, tid, cv, cvsetup); else mla_unit<false>(it & 7, (it >> 3) * 256, QM, KM, VM, Y, lds, tid, cv, cvsetup); }
        if (G == 256) {
            __syncthreads();
            LAS float* scr = (LAS float*)(lds + wave * 16640);
            for (int ci = cv.ci; ci < CONV_NCI; ++ci) { const int item = cv.item0 + ci, mat = item >> 8, which = mat >> 5, e = mat & 31, rr = item & 255, kb = rr >> 5, nb = rr & 31, n0 = nb * 32;
                if (which < 2) tr_item8(args.in[which == 0 ? I_WG : I_WU] + (size_t)e * DM * DFF, 1024, 1024, kb * 128, n0, W1F8, (size_t)e * 2048 + (n0 >> 7) * 256 + which * 128 + (n0 & 127), scr, lane);
                else tr_item8(args.in[I_WD] + (size_t)e * DFF * DM, 1024, 1024, kb * 128, n0, W2F8, (size_t)e * 1024 + n0, scr, lane); }
        }
#endif
    }
    SEAM(5);

#ifdef SELFCHECK
    {
        xcd_barrier(bar);
        unsigned* flags = (unsigned*)(ws + WS_CTL) + 2048;
        LAS float* sbuf = (LAS float*)lds;
        LAS float* red = (LAS float*)(lds + 16400 * 4);
        if (bx < 128) {
            const int h = bx & 7; const int t = (bx < 8) ? bx * 37 : (bx < 16 ? T - 1 - (bx - 8) * 11 : (int)(((unsigned)bx * 2654435761u) >> 18) & (T - 1));
            const unsigned char* q = (const unsigned char*)QM + ((size_t)h * T + t) * 128;
            float lm = -INFINITY;
            for (int j = tid; j < LTOK; j += 512) { float a = 0.f;
                for (int d = 0; d < 96; ++d) a += __builtin_amdgcn_cvt_f32_fp8((int)q[d], 0) * __builtin_amdgcn_cvt_f32_fp8((int)((const unsigned char*)KM)[km_off(h, j, d)], 0);
                a *= (1.0f / 64.0f);
                sbuf[j] = a; lm = fmaxf(lm, a); }
            lm = wave_max(lm); if (lane == 0) red[wave] = lm; __syncthreads();
            float m = red[0]; for (int w = 1; w < 8; ++w) m = fmaxf(m, red[w]); __syncthreads();
            float l = 0.f;
            for (int j = tid; j < LTOK; j += 512) l += exp2f(sbuf[j] - m);
            l = wave_sum(l);
            if (lane == 0) red[wave * 66 + 64] = l;
#pragma unroll 1
            for (int dg = 0; dg < 8; ++dg) { float o[8];
#pragma unroll
                for (int d = 0; d < 8; ++d) o[d] = 0.f;
                for (int j = tid; j < LTOK; j += 512) { const float pj = exp2f(sbuf[j] - m); const bf16_t* v = VM + vm_off(h, j, dg * 8);
#pragma unroll
                    for (int d = 0; d < 8; ++d) o[d] += pj * bflo(v[d]); }
#pragma unroll
                for (int d = 0; d < 8; ++d) { const float od = wave_sum(o[d]); if (lane == 0) red[wave * 66 + dg * 8 + d] = od; } }
            __syncthreads();
            if (tid == 0) { float lt = 0.f; for (int w = 0; w < 8; ++w) lt += red[w * 66 + 64]; float mx = 0.f, me = 0.f;
                for (int d = 0; d < 64; ++d) { float od = 0.f; for (int w = 0; w < 8; ++w) od += red[w * 66 + d]; od /= lt; const float yk = bflo(Y[(size_t)t * DM + 512 + h * 64 + d]); mx = fmaxf(mx, fabsf(od)); me = fmaxf(me, fabsf(od - yk)); }
                const float rel = me / (mx + 1e-12f); atomicMax(flags + 0, __float_as_uint(rel)); }
        } else {
            const int b2 = bx - 128, hq = b2 & 7, kvh = hq >> 2;
            const int t = (b2 < 8) ? b2 * 19 : (b2 < 16 ? T - 1 - (b2 - 8) * 23 : (b2 < 24 ? 120 + (b2 - 16) * 3 : (int)(((unsigned)b2 * 2654435761u) >> 18) & (T - 1)));
            const bf16_t* q = PROJ + (size_t)t * INWP + hq * 64;
            const float slope2 = exp2f(-(float)(hq + 1)) * LOG2E, sink2 = args.in[I_SINK][hq] * LOG2E;
            float qss = 0.f; for (int d = 0; d < 64; ++d) qss += bflo(q[d]) * bflo(q[d]);
            const float qrs = rstd_of(qss, 64.f) * QSCALE_SWA;
            float sc = -INFINITY; int krow = -1;
            if (tid < 16) krow = T + tid; else if (tid < 16 + 257) { const int key = t - 128 + (tid - 16); if (key >= 0 && key < T) krow = key; }
            if (krow >= 0) { const bf16_t* k = PROJ + (size_t)krow * INWP + 512 + kvh * 64; float kss = 0.f; for (int d = 0; d < 64; ++d) kss += bflo(k[d]) * bflo(k[d]);
                const float krs = rstd_of(kss, 64.f); float a = 0.f;
                for (int d = 0; d < 64; ++d) a += (bflo(q[d]) * qrs * args.in[I_SQG][d]) * (bflo(k[d]) * krs * args.in[I_SKG][d]);
                if (tid >= 16) { const int df = krow - t; a -= slope2 * (float)(df < 0 ? -df : df); } sc = a; }
            float lm = wave_max(sc); if (lane == 0) red[wave] = lm; __syncthreads();
            float m = sink2; for (int w = 0; w < 8; ++w) m = fmaxf(m, red[w]); __syncthreads();
            const float pj = krow >= 0 ? exp2f(sc - m) : 0.f;
            float l = wave_sum(pj); float o[64];
            for (int d = 0; d < 64; ++d) { const float vv = krow >= 0 ? bflo(PROJ[(size_t)krow * INWP + 640 + kvh * 64 + d]) : 0.f; o[d] = wave_sum(pj * vv); }
            if (lane == 0) red[wave * 66 + 64] = l;
#pragma unroll
            for (int d = 0; d < 64; ++d) if (lane == 0) red[wave * 66 + d] = o[d];
            __syncthreads();
            if (tid == 0) { float lt = exp2f(sink2 - m); for (int w = 0; w < 8; ++w) lt += red[w * 66 + 64]; float mx = 0.f, me = 0.f;
                for (int d = 0; d < 64; ++d) { float od = 0.f; for (int w = 0; w < 8; ++w) od += red[w * 66 + d]; od /= lt; const float yk = bflo(Y[(size_t)t * DM + hq * 64 + d]); mx = fmaxf(mx, fabsf(od)); me = fmaxf(me, fabsf(od - yk)); }
                const float rel = me / (mx + 1e-12f); atomicMax(flags + 1, __float_as_uint(rel)); }
        }
        __syncthreads();
        {
            const int h = bx & 7; const int r = (bx < 8) ? T + bx : (bx < 16 ? bx * 5 : (int)(((unsigned)(bx + 77) * 2654435761u) >> 18) & (T - 1));
            LAS float* up = (LAS float*)lds;
            const bf16_t* pr = PROJ + (size_t)r * INWP;
            float qss = 0.f, kss = 0.f;
            for (int k = 0; k < 256; ++k) qss += bflo(pr[768 + k]) * bflo(pr[768 + k]);
            for (int k = 0; k < 128; ++k) kss += bflo(pr[1024 + k]) * bflo(pr[1024 + k]);
            const float rq = rstd_of(qss, 256.f), rkv = rstd_of(kss, 128.f);
            if (tid < 96) { float a = 0.f; for (int k = 0; k < 256; ++k) a += bflo(pr[768 + k]) * rq * args.in[I_QLG][k] * args.in[I_WQUP][(size_t)k * 768 + h * 96 + tid]; up[tid] = a; }
            else if (tid < 224) { const int d = tid - 96; float a = 0.f; for (int k = 0; k < 128; ++k) a += bflo(pr[1024 + k]) * rkv * args.in[I_KVLG][k] * args.in[I_WKVUP][(size_t)k * 1024 + h * 128 + d]; up[tid] = a; }
            __syncthreads();
            if (tid == 0) {
                const int pos = r < T ? r + NMETA : r - T; float me = 0.f, mx = 0.f;
                LAS float* kv = up + 224; LAS float* q = up + 320; float ss = 0.f;
                for (int d = 0; d < 64; ++d) kv[d] = up[96 + d];
                for (int d = 0; d < 32; ++d) kv[64 + d] = bflo(pr[1152 + d]);
                for (int d = 0; d < 96; ++d) ss += kv[d] * kv[d];
                float rs = rstd_of(ss, 96.f);
                for (int d = 0; d < 96; ++d) kv[d] = kv[d] * rs * args.in[I_MKG][d];
                for (int i = 0; i < 16; ++i) { const float ang = (float)pos * (1.0f / powf(10000.0f, (float)i / 16.0f)); const float c = cosf(ang), sn = sinf(ang); const float x1 = kv[64 + i], x2 = kv[80 + i]; kv[64 + i] = x1 * c - x2 * sn; kv[80 + i] = x1 * sn + x2 * c; }
                for (int d = 0; d < 96; ++d) { const float got = 0.25f * __builtin_amdgcn_cvt_f32_fp8((int)((const unsigned char*)KM)[km_off(h, r, d)], 0); mx = fmaxf(mx, fabsf(kv[d])); me = fmaxf(me, fabsf(kv[d] - got)); }
                float rel = me / (mx + 1e-12f);
                me = 0.f; mx = 0.f;
                for (int d = 0; d < 64; ++d) { const float want = up[160 + d], got = bflo(VM[vm_off(h, r, d)]); mx = fmaxf(mx, fabsf(want)); me = fmaxf(me, fabsf(want - got)); }
                rel = fmaxf(rel, me / (mx + 1e-12f));
                if (r < T) { ss = 0.f; me = 0.f; mx = 0.f;
                    for (int d = 0; d < 96; ++d) { q[d] = up[d]; ss += q[d] * q[d]; }
                    rs = rstd_of(ss, 96.f) * QSCALE_MLA;
                    for (int d = 0; d < 96; ++d) q[d] = q[d] * rs * args.in[I_MQG][d];
                    for (int i = 0; i < 16; ++i) { const float ang = (float)pos * (1.0f / powf(10000.0f, (float)i / 16.0f)); const float c = cosf(ang), sn = sinf(ang); const float x1 = q[64 + i], x2 = q[80 + i]; q[64 + i] = x1 * c - x2 * sn; q[80 + i] = x1 * sn + x2 * c; }
                    for (int d = 0; d < 96; ++d) { const float got = 0.0625f * __builtin_amdgcn_cvt_f32_fp8((int)((const unsigned char*)QM)[((size_t)h * T + r) * 128 + d], 0); mx = fmaxf(mx, fabsf(q[d])); me = fmaxf(me, fabsf(q[d] - got)); }
                    rel = fmaxf(rel, me / (mx + 1e-12f)); }
                atomicMax(flags + 3, __float_as_uint(rel));
            }
        }
        {
            const int r = (int)(((unsigned)(bx * 512 + tid) * 2654435761u) >> 12) % LTOK, i = tid & 15; const int pos = r < T ? r + NMETA : r - T;
            const float ang = (float)pos * (1.0f / powf(10000.0f, (float)i / 16.0f));
            const float e = fmaxf(fabsf(cosf(ang) - ROPE[((size_t)r * 16 + i) * 2]), fabsf(sinf(ang) - ROPE[((size_t)r * 16 + i) * 2 + 1]));
            atomicMax(flags + 2, __float_as_uint(e));
        }
        __syncthreads();
    }
#endif
    if (IN(6)) REPS(6) {
        int k8_ = DM / 2; asm volatile("" : "+s"(k8_));
        pg8::Gemm g{Y, W_OUT_T, T, DM, k8_}; pg8::StaticOrder S; S.init(T, DM, G, bx);
        pg8::EpiResBf16S E{x, H2B, DM, 1.0f / (YSC * 256.0f)};
        pg8::gemm_phase<pg8::EpiResBf16S, pg8::StaticOrder, true, true, true>(lds, g, S, E);
    }
    SEAM(6);
    if (IN(7)) REPS(7) {
        LAS float* red = (LAS float*)lds;
        LAS float* ssq = (LAS float*)(lds + 32768);
        LAS int* hist = (LAS int*)(lds + MISC_OFF + 256);
        const int tb = wave >> 2, kq = wave & 3, r32 = lane & 31, hh = lane >> 5;
        for (int c = bx; c < 256; c += G) {
            if (tid < 32) hist[tid] = 0;
            const int t = c * 64 + tb * 32 + r32;
            const bf16_t* hrow = H2B + (size_t)t * DM + kq * 256 + hh * 8;
            const bf16_t* wh = (const bf16_t*)(ws + WS_RWH) + r32 * 1024 + kq * 256 + hh * 8; const bf16_t* wl = (const bf16_t*)(ws + WS_RWL) + r32 * 1024 + kq * 256 + hh * 8;
            f32x16 acc = {}; float ss = 0.f;
#pragma unroll 8
            for (int ks = 0; ks < 16; ++ks) {
                const u32x4 bh = *(const u32x4*)(hrow + ks * 16);
                const bf16x8 ah = *(const bf16x8*)(wh + ks * 16), al = *(const bf16x8*)(wl + ks * 16);
                float xv[8]; unpack8(bh, xv);
#pragma unroll
                for (int i = 0; i < 8; ++i) ss += xv[i] * xv[i];
                acc = __builtin_amdgcn_mfma_f32_32x32x16_bf16(ah, __builtin_bit_cast(bf16x8, bh), acc, 0, 0, 0);
                acc = __builtin_amdgcn_mfma_f32_32x32x16_bf16(al, __builtin_bit_cast(bf16x8, bh), acc, 0, 0, 0);
            }
            ss += __shfl_xor(ss, 32);
            if (kq != 0) {
#pragma unroll
                for (int r = 0; r < 16; ++r) red[((tb * 3 + kq - 1) * 16 + r) * 64 + lane] = acc[r];
            }
            if (hh == 0) ssq[(tb * 4 + kq) * 32 + r32] = ss;
            __syncthreads();
            if (kq == 0) {
#pragma unroll
                for (int q = 0; q < 3; ++q)
#pragma unroll
                    for (int r = 0; r < 16; ++r) acc[r] += red[((tb * 3 + q) * 16 + r) * 64 + lane];
                const float rs = rstd_of((ssq[(tb * 4 + 0) * 32 + r32] + ssq[(tb * 4 + 1) * 32 + r32]) + (ssq[(tb * 4 + 2) * 32 + r32] + ssq[(tb * 4 + 3) * 32 + r32]), 1024.f);
                float v0 = -INFINITY, v1 = -INFINITY, v2 = -INFINITY, v3 = -INFINITY; int i0 = 0, i1 = 0, i2 = 0, i3 = 0;
#define P7_INS(VAL, IDX) do { float x_ = (VAL); int xi_ = (IDX); bool c_; float tf_; int ti_; \
                    c_ = x_ > v0; tf_ = c_ ? v0 : x_; ti_ = c_ ? i0 : xi_; v0 = c_ ? x_ : v0; i0 = c_ ? xi_ : i0; x_ = tf_; xi_ = ti_; \
                    c_ = x_ > v1; tf_ = c_ ? v1 : x_; ti_ = c_ ? i1 : xi_; v1 = c_ ? x_ : v1; i1 = c_ ? xi_ : i1; x_ = tf_; xi_ = ti_; \
                    c_ = x_ > v2; tf_ = c_ ? v2 : x_; ti_ = c_ ? i2 : xi_; v2 = c_ ? x_ : v2; i2 = c_ ? xi_ : i2; x_ = tf_; xi_ = ti_; \
                    c_ = x_ > v3; v3 = c_ ? x_ : v3; i3 = c_ ? xi_ : i3; } while (0)
#pragma unroll
                for (int r = 0; r < 16; ++r) { const int e = crow(r, hh); P7_INS(acc[r] * rs + args.in[I_RB][e], e); }
                {
                    const float w0 = __shfl_xor(v0, 32), w1 = __shfl_xor(v1, 32), w2 = __shfl_xor(v2, 32), w3 = __shfl_xor(v3, 32);
                    const int j0 = __shfl_xor(i0, 32), j1 = __shfl_xor(i1, 32), j2 = __shfl_xor(i2, 32), j3 = __shfl_xor(i3, 32);
                    P7_INS(w0, j0); P7_INS(w1, j1); P7_INS(w2, j2); P7_INS(w3, j3);
                }
#undef P7_INS
                if (hh == 0) {
                    const float e1 = __expf(v1 - v0), e2 = __expf(v2 - v0), e3 = __expf(v3 - v0); const float inv = 1.0f / (1.0f + e1 + e2 + e3);
                    const int k0 = __hip_atomic_fetch_add(hist + i0, 1, __ATOMIC_RELAXED, __HIP_MEMORY_SCOPE_WORKGROUP), k1 = __hip_atomic_fetch_add(hist + i1, 1, __ATOMIC_RELAXED, __HIP_MEMORY_SCOPE_WORKGROUP);
                    const int k2 = __hip_atomic_fetch_add(hist + i2, 1, __ATOMIC_RELAXED, __HIP_MEMORY_SCOPE_WORKGROUP), k3 = __hip_atomic_fetch_add(hist + i3, 1, __ATOMIC_RELAXED, __HIP_MEMORY_SCOPE_WORKGROUP);
                    typedef int i32x4t __attribute__((ext_vector_type(4)));
                    *(i32x4t*)(TOPE + t * 4) = (i32x4t){i0, i1, i2, i3}; *(f32x4*)(TOPG + t * 4) = (f32x4){inv, e1 * inv, e2 * inv, e3 * inv}; *(i32x4t*)(TRANK + t * 4) = (i32x4t){k0, k1, k2, k3};
                }
            }
            __syncthreads();
            if (tid < 32) CCNT[c * 32 + tid] = hist[tid];
            __syncthreads();
        }
    }
    SEAM(7);
    if (IN(8)) REPS(8) {
        LAS int* red = (LAS int*)lds;
        LAS int* base_l = (LAS int*)(lds + 8192); LAS int* pst_l = base_l + 32;
        f32x4 g[4];
#pragma unroll
        for (int j = 0; j < 4; ++j) g[j] = *(const f32x4*)(args.in[I_FNG] + lane * 4 + 256 * j);
        for (int c = bx; c < 256; c += G) {
            { const int e = tid & 31, part = tid >> 5; int slt = 0, sall = 0;
              for (int q = 0; q < 16; ++q) { const int cc = part * 16 + q; const int v = CCNT[cc * 32 + e]; sall += v; if (cc < c) slt += v; }
              red[part * 32 + e] = slt; red[512 + part * 32 + e] = sall; }
            __syncthreads();
            if (tid < 32) { int b = 0, tot = 0; for (int p = 0; p < 16; ++p) { b += red[p * 32 + tid]; tot += red[512 + p * 32 + tid]; } base_l[tid] = b; pst_l[32 + tid] = tot; if (c == 0) ETOT[tid] = tot; }
            __syncthreads();
            if (tid == 0) { int acc = 0; for (int e = 0; e < 32; ++e) { pst_l[e] = acc; acc += ((pst_l[32 + e] + 255) >> 8) << 8; } }
            __syncthreads();
            for (int tt = wave * 2; tt < 64; tt += NWAVES * 2) { const int t = c * 64 + tt;
                int slot = 0;
                if (lane < 8) { const int e = TOPE[t * 4 + lane]; slot = pst_l[e] + base_l[e] + TRANK[t * 4 + lane]; SGATE[slot] = TOPG[t * 4 + lane]; TSLOT[t * 4 + lane] = slot; }
                f32x4 v[2][4];
#pragma unroll
                for (int u = 0; u < 2; ++u)
#pragma unroll
                    for (int j = 0; j < 4; ++j) { const u32x2 w = ((const u32x2*)(H2B + (size_t)(t + u) * DM))[lane + 64 * j]; v[u][j] = (f32x4){bflo(w.x), bfhi(w.x), bflo(w.y), bfhi(w.y)}; }
#pragma unroll
                for (int u = 0; u < 2; ++u) {
                    const int s0 = __shfl(slot, 4 * u + 0), s1 = __shfl(slot, 4 * u + 1), s2 = __shfl(slot, 4 * u + 2), s3 = __shfl(slot, 4 * u + 3);
                    float ss = 0.f;
#pragma unroll
                    for (int j = 0; j < 4; ++j) ss += (v[u][j].x * v[u][j].x + v[u][j].y * v[u][j].y) + (v[u][j].z * v[u][j].z + v[u][j].w * v[u][j].w);
                    const float rs = rstd_of(wave_sum(ss), 1024.f);
#pragma unroll
                    for (int j = 0; j < 4; ++j) { const f32x4 y = v[u][j] * (rs * 8.0f) * g[j]; const unsigned w = pg8::pk4_fp8(y.x, y.y, y.z, y.w);
                        ((unsigned*)(XS8 + (size_t)s0 * DM))[lane + 64 * j] = w; ((unsigned*)(XS8 + (size_t)s1 * DM))[lane + 64 * j] = w;
                        ((unsigned*)(XS8 + (size_t)s2 * DM))[lane + 64 * j] = w; ((unsigned*)(XS8 + (size_t)s3 * DM))[lane + 64 * j] = w; }
                }
            }
            __syncthreads();
        }
    }
    SEAM(8);
    LAS int* tile_e = (LAS int*)(lds + MISC_OFF + 512);
    if (IN(9) || IN(10)) {
        if (tid == 0) { int n = 0; for (int e = 0; e < 32; ++e) { const int nt = (ETOT[e] + 255) >> 8; for (int q = 0; q < nt; ++q) tile_e[n++] = e; } tile_e[MAXTILES] = n; }
        __syncthreads();
    }
    if (IN(9)) REPS(9) {
        const int nMt = tile_e[MAXTILES];
        int k8_ = DM / 2; asm volatile("" : "+s"(k8_));
        pg8::Gemm g{(const bf16_t*)XS8, (const bf16_t*)W1F8, 0, 0, k8_}; pg8::MoeOrder S; S.init(nMt, 8, G, bx, (const PG8_LAS int*)tile_e);
        pg8::EpiSwiglu8 E{ACT8, args.in[I_BG], args.in[I_BU]};
        pg8::gemm_phase<pg8::EpiSwiglu8, pg8::MoeOrder, true, true, true>(lds, g, S, E);
    }
    SEAM(9);
    if (IN(10)) REPS(10) {
        const int nMt = tile_e[MAXTILES];
        int k8_ = DFF / 2; asm volatile("" : "+s"(k8_));
        pg8::Gemm g{(const bf16_t*)ACT8, (const bf16_t*)W2F8, 0, 0, k8_}; pg8::MoeOrder S; S.init(nMt, 4, G, bx, (const PG8_LAS int*)tile_e);
        pg8::EpiDown8 E{(unsigned char*)YS, args.in[I_BD], SGATE, 1.0f / 2048.0f};
        pg8::gemm_phase<pg8::EpiDown8, pg8::MoeOrder, true, true, true>(lds, g, S, E);
    }
    SEAM(10);
    if (IN(11)) {
        const unsigned char* y8 = (const unsigned char*)YS;
        for (int t0 = gw * 2; t0 < T; t0 += NGW * 2) {
            int sl[2][4]; u32x2 hw[2][4]; int yv[2][4][4];
#pragma unroll
            for (int u = 0; u < 2; ++u) { const int t = t0 + u;
#pragma unroll
                for (int k = 0; k < 4; ++k) sl[u][k] = TSLOT[t * 4 + k]; }
#pragma unroll
            for (int u = 0; u < 2; ++u)
#pragma unroll
                for (int j = 0; j < 4; ++j) { hw[u][j] = ((const u32x2*)(H2B + (size_t)(t0 + u) * DM))[lane + 64 * j];
#pragma unroll
                    for (int k = 0; k < 4; ++k) yv[u][j][k] = ((const int*)(y8 + (size_t)sl[u][k] * DM))[lane + 64 * j]; }
#define F8B(w, i) __builtin_amdgcn_cvt_f32_fp8(w, i)
#pragma unroll
            for (int u = 0; u < 2; ++u) { float* hrow = OUT + (size_t)(t0 + u) * DM;
#pragma unroll
                for (int j = 0; j < 4; ++j) { const int a = yv[u][j][0], b = yv[u][j][1], c = yv[u][j][2], d = yv[u][j][3];
                    f32x4 h = (f32x4){bflo(hw[u][j].x), bfhi(hw[u][j].x), bflo(hw[u][j].y), bfhi(hw[u][j].y)};
                    h.x += ((F8B(a, 0) + F8B(b, 0)) + (F8B(c, 0) + F8B(d, 0))) * 0.0625f; h.y += ((F8B(a, 1) + F8B(b, 1)) + (F8B(c, 1) + F8B(d, 1))) * 0.0625f;
                    h.z += ((F8B(a, 2) + F8B(b, 2)) + (F8B(c, 2) + F8B(d, 2))) * 0.0625f; h.w += ((F8B(a, 3) + F8B(b, 3)) + (F8B(c, 3) + F8B(d, 3))) * 0.0625f;
                    *(f32x4*)(hrow + lane * 4 + 256 * j) = h; } }
#undef F8B
        }
    }

#ifdef SELFCHECK
    {
        xcd_barrier(bar);
        const unsigned* flags = (const unsigned*)(ws + WS_CTL) + 2048;
        const float e0 = __uint_as_float(__hip_atomic_load(flags + 0, __ATOMIC_RELAXED, __HIP_MEMORY_SCOPE_AGENT)), e1 = __uint_as_float(__hip_atomic_load(flags + 1, __ATOMIC_RELAXED, __HIP_MEMORY_SCOPE_AGENT)), e2 = __uint_as_float(__hip_atomic_load(flags + 2, __ATOMIC_RELAXED, __HIP_MEMORY_SCOPE_AGENT)), e3 = __uint_as_float(__hip_atomic_load(flags + 3, __ATOMIC_RELAXED, __HIP_MEMORY_SCOPE_AGENT));
        float E = 0.f;
#ifndef SC_TOL
#define SC_TOL 0.03f
#endif
        if (!(e0 <= SC_TOL)) E += 1.f; if (!(e1 <= SC_TOL)) E += 2.f; if (!(e2 <= 2e-3f)) E += 4.f; if (!(e3 <= SC_TOL)) E += 8.f;
#ifdef SC_REPORT
        E = SC_REPORT == 0 ? e0 * 1000.f : SC_REPORT == 1 ? e1 * 1000.f : SC_REPORT == 2 ? e2 * 1000.f : e3 * 1000.f;
#endif
        if (E != 0.f) for (int t = gw; t < T; t += NGW) { float* hrow = OUT + (size_t)t * DM;
#pragma unroll
            for (int j = 0; j < 4; ++j) { f32x4 h = *(const f32x4*)(hrow + lane * 4 + 256 * j); h = h * (1.f + E); *(f32x4*)(hrow + lane * 4 + 256 * j) = h; } }
    }
#endif
#undef IN
#undef SEAM
#undef W_IN_T
#undef W_OUT_T
#undef W_QUP_T
#undef W_KVUP_T
#undef W1_T
#undef W2_T
#undef ROPE
#undef A_N
#undef PROJ
#undef QS
#undef KS
#undef VS
#undef QL
#undef KVL
#undef KR
#undef QU
#undef KVU
#undef QM
#undef KM
#undef VM
#undef Y
#undef XS
#undef ACT
#undef YS
#undef TOPE
#undef TOPG
#undef TRANK
#undef TSLOT
#undef SGATE
#undef CCNT
#undef ETOT
}

extern "C" void kernel_launch(void* const* d_in, const int* in_sizes, int n_in, void* d_out, int out_size, void* d_ws, size_t ws_size, hipStream_t stream) {
    static int grid = 0;
    if (grid == 0) {
        if (n_in != N_IN || in_sizes[0] != T * DM || out_size != T * DM || ws_size < WS_END) { fprintf(stderr, "kernel_launch: unexpected shapes: n_in %d in0 %d out %d ws %zu (need %zu)\n", n_in, n_in > 0 ? in_sizes[0] : -1, out_size, ws_size, (size_t)WS_END); grid = -1; return; }
        int dev = 0, cus = 0, per_cu = 0;
        if (hipGetDevice(&dev) != hipSuccess || hipDeviceGetAttribute(&cus, hipDeviceAttributeMultiprocessorCount, dev) != hipSuccess) { grid = -1; return; }
        if (hipFuncSetAttribute((const void*)fwd, hipFuncAttributeMaxDynamicSharedMemorySize, LDS_BYTES) != hipSuccess) { fprintf(stderr, "kernel_launch: hipFuncSetAttribute failed\n"); grid = -1; return; }
        if (hipOccupancyMaxActiveBlocksPerMultiprocessor(&per_cu, (const void*)fwd, NWAVES * 64, LDS_BYTES) != hipSuccess || per_cu < 1) { fprintf(stderr, "kernel_launch: occupancy query reports %d blocks per CU\n", per_cu); grid = -1; return; }
        (void)hipGetLastError();
        grid = cus;
    }
    if (grid < 0) return;
    (void)hipMemsetAsync((char*)d_ws + WS_CTL, 0, CTL_ZERO_BYTES, stream);
    Args a{};
    for (int i = 0; i < N_IN; ++i) a.in[i] = (const float*)d_in[i];
    a.out = (float*)d_out; a.ws = (unsigned char*)d_ws;
#if MK_ONE_LAUNCH
    a.ph_lo = 0; a.ph_hi = NPHASE;
    hipLaunchKernelGGL(fwd, dim3(grid), dim3(NWAVES * 64), LDS_BYTES, stream, a);
#else
    for (int p = 0; p < NPHASE; ++p) { a.ph_lo = p; a.ph_hi = p + 1; hipLaunchKernelGGL(fwd, dim3(grid), dim3(NWAVES * 64), LDS_BYTES, stream, a); }
#endif
    const hipError_t le = hipPeekAtLastError();
    if (le != hipSuccess) fprintf(stderr, "kernel_launch: launch failed: %s\n", hipGetErrorName(le));
}
```
